# Optimizing an MI355X kernel written in HIP

```python
import jax, jax.numpy as jnp
from jax import lax
import numpy as np

D_MODEL = 1024
BATCH = 32
SEQ = 256
DEPTH = 2
DEC_BATCH = 8
DEC_SEQ = 4096
PAST_LEN = 256

GRID_W = 64
N_EVEN = (DEPTH + 1) // 2
N_ODD = DEPTH // 2
N_SUB = 3
HEAD_DIM = 64
N_RET = 8
RET_DK = 64
RET_DV = 64
RET_CHUNK = 128
RET_GN_EPS = 1e-5
N_Q = 8
N_KV = 2
Q_GROUP = N_Q // N_KV
Q_BLOCK = 128
ROPE_THETA = 10000.0
N_NA = 16
NA_KR_MAX = 8
NA_KC = 16
D_FF = 2816
EPS = 1e-6
RET_W = N_RET * RET_DK
RET_VW = N_RET * RET_DV
GQA_W = N_Q * HEAD_DIM
KV_W = N_KV * HEAD_DIM
AB_IN = 2 * RET_W + 2 * RET_VW + GQA_W + 2 * KV_W
AB_SPLITS = (RET_W, 2 * RET_W, 2 * RET_W + RET_VW, 2 * RET_W + 2 * RET_VW,
             2 * RET_W + 2 * RET_VW + GQA_W, 2 * RET_W + 2 * RET_VW + GQA_W + KV_W)
AB_OUT = RET_VW + GQA_W
NA_W = N_NA * HEAD_DIM

kernel_name = 'hybrid_flow_retention_gqa_natten'


def rmsnorm(x, g):
    xf = x.astype(jnp.float32)
    y = xf * lax.rsqrt(jnp.mean(xf * xf, axis=-1, keepdims=True) + EPS)
    return (y * g.astype(jnp.float32)).astype(x.dtype)


def softmax_f32(s, dtype):
    return jax.nn.softmax(s.astype(jnp.float32), axis=-1).astype(dtype)


def swiglu(h, w_in, w_out):
    gate, up = jnp.split(h @ w_in, 2, axis=-1)
    return (jax.nn.silu(gate) * up) @ w_out


def adaln_sublayer(x, mod, s, g_pre, g_post, fn, weight):
    shift = mod[:, 3 * s, None]
    scale = mod[:, 3 * s + 1, None]
    gate = mod[:, 3 * s + 2, None]
    h = rmsnorm(x, g_pre) * (1 + scale) + shift
    y, aux = fn(h)
    return x + weight * gate * rmsnorm(y, g_post), aux


def axial_rope(x):
    n = x.shape[1]
    t = jnp.arange(n)
    rows, cols = t // GRID_W, t % GRID_W
    half = HEAD_DIM // 2
    quarter = half // 2
    inv = ROPE_THETA ** (-jnp.arange(quarter, dtype=jnp.float32) / quarter)

    def rot(xp, pos):
        ang = pos.astype(jnp.float32)[:, None] * inv[None, :]
        cos = jnp.cos(ang)[None, :, None, :].astype(x.dtype)
        sin = jnp.sin(ang)[None, :, None, :].astype(x.dtype)
        x1, x2 = xp[..., :quarter], xp[..., quarter:]
        return jnp.concatenate([x1 * cos - x2 * sin, x2 * cos + x1 * sin], axis=-1)

    return jnp.concatenate([rot(x[..., :half], rows), rot(x[..., half:], cols)], axis=-1)


def attend(q, k, v):
    s = jnp.einsum('bqhgd,bkhd->bhgqk', q, k) * (HEAD_DIM ** -0.5)
    p = softmax_f32(s, v.dtype)
    return jnp.einsum('bhgqk,bkhd->bqhgd', p, v)


def attend_query_blocks(q, k, v):
    b, n = q.shape[0], q.shape[1]
    nb = n // Q_BLOCK
    qb = q.reshape((b, nb, Q_BLOCK) + q.shape[2:]).swapaxes(0, 1)
    ob = lax.map(lambda qq: attend(qq, k, v), qb)
    return ob.swapaxes(0, 1).reshape(q.shape)


def retention_chunkwise(q, k, v, log_gamma, init_state, strict):
    b, nh, seq_len, dk = q.shape
    dv = v.shape[-1]
    c = RET_CHUNK
    nc = seq_len // c
    qc = q.reshape(b, nh, nc, c, dk)
    kc = k.reshape(b, nh, nc, c, dk)
    vc = v.reshape(b, nh, nc, c, dv)
    idx = jnp.arange(c, dtype=jnp.float32)
    lg = log_gamma.astype(jnp.float32)[:, None]
    diff = idx[:, None] - idx[None, :]
    mask = (diff > 0) if strict else (diff >= 0)
    dmat = jnp.where(mask[None], jnp.exp(lg[:, :, None] * jnp.maximum(diff, 0.0)[None]), 0.0).astype(q.dtype)
    q_dec = jnp.exp(lg * (idx + 1.0)).astype(q.dtype)
    k_dec = jnp.exp(lg * (c - 1.0 - idx)).astype(q.dtype)
    c_dec = jnp.exp(lg[:, 0] * c).astype(q.dtype)[None, :, None, None]
    s = jnp.einsum('bhnid,bhnjd->bhnij', qc, kc) * dmat[None, :, None]
    intra = jnp.einsum('bhnij,bhnje->bhnie', s, vc)
    kv = jnp.einsum('bhncd,bhnce,hc->nbhde', kc, vc, k_dec)

    def step(state, kv_n):
        return c_dec * state + kv_n, state

    final_state, prev_states = lax.scan(step, init_state.astype(q.dtype), kv)
    cross = jnp.einsum('bhncd,nbhde,hc->bhnce', qc, prev_states, q_dec)
    return (intra + cross).reshape(b, nh, seq_len, dv), final_state


def bidirectional_retention(q, k, v, lg_f, lg_b, s_f, s_b):
    o_f, fin_f = retention_chunkwise(q, k, v, lg_f, s_f, False)
    o_b, fin_b = retention_chunkwise(jnp.flip(q, 2), jnp.flip(k, 2), jnp.flip(v, 2), lg_b, s_b, True)
    return o_f + jnp.flip(o_b, 2), fin_f, fin_b


def head_groupnorm(o, g):
    of = o.astype(jnp.float32)
    mu = jnp.mean(of, axis=-1, keepdims=True)
    var = jnp.mean(jnp.square(of - mu), axis=-1, keepdims=True)
    y = (of - mu) * lax.rsqrt(var + RET_GN_EPS)
    b, nh, seq_len, dv = o.shape
    y = y.transpose(0, 2, 1, 3).reshape(b, seq_len, nh * dv)
    return (y * g.astype(jnp.float32)).astype(o.dtype)


def mixer_ab(h, w_in, w_out, dec_f, dec_b, gn, qn, kn, ctx):
    b, n, _ = h.shape
    rq, rk, rv, rg, gq, gk, gv = jnp.split(h @ w_in, AB_SPLITS, axis=-1)
    to_heads = lambda a, nh: a.reshape(b, n, nh, -1)
    rq_h = to_heads(rq, N_RET).transpose(0, 2, 1, 3)
    rk_h = to_heads(rk, N_RET).transpose(0, 2, 1, 3) * (RET_DK ** -0.5)
    rv_h = to_heads(rv, N_RET).transpose(0, 2, 1, 3)
    lg_f = jax.nn.log_sigmoid(dec_f.astype(jnp.float32))
    lg_b = jax.nn.log_sigmoid(dec_b.astype(jnp.float32))
    if ctx is None:
        s_f = jnp.zeros((b, N_RET, RET_DK, RET_DV), h.dtype)
        s_b = jnp.zeros((b, N_RET, RET_DK, RET_DV), h.dtype)
    else:
        s_f, s_b = ctx[2], ctx[3]
    o_r, fin_f, fin_b = bidirectional_retention(rq_h, rk_h, rv_h, lg_f, lg_b, s_f, s_b)
    y_ret = head_groupnorm(o_r, gn) * jax.nn.silu(rg)
    q = rmsnorm(to_heads(gq, N_Q), qn)
    k = rmsnorm(to_heads(gk, N_KV), kn)
    v = to_heads(gv, N_KV)
    if ctx is None:
        y_att = attend(q.reshape(b, n, N_KV, Q_GROUP, HEAD_DIM), k, v)
        aux = (k, v, fin_f, fin_b)
    else:
        q = axial_rope(q)
        k_all = jnp.concatenate([axial_rope(k), ctx[0]], axis=1)
        v_all = jnp.concatenate([v, ctx[1]], axis=1)
        y_att = attend_query_blocks(q.reshape(b, n, N_KV, Q_GROUP, HEAD_DIM), k_all, v_all)
        aux = None
    y = jnp.concatenate([y_ret, y_att.reshape(b, n, GQA_W)], axis=-1) @ w_out
    return y, aux


def neighbourhood_attention(q, k, v, k_ctx, v_ctx, rpb):
    b, n, nh, d = q.shape
    rows = n // GRID_W
    kr = min(NA_KR_MAX, rows)
    qg = q.reshape(b, rows, GRID_W, nh, d)
    kg = k.reshape(b, rows, GRID_W, nh, d)
    vg = v.reshape(b, rows, GRID_W, nh, d)
    cols = jnp.arange(GRID_W)
    c0 = jnp.clip(cols - NA_KC // 2, 0, GRID_W - NA_KC)
    col_idx = c0[:, None] + jnp.arange(NA_KC)[None, :]
    dc = col_idx - cols[:, None] + (NA_KC - 1)
    scale = HEAD_DIM ** -0.5
    rpb = rpb.astype(q.dtype)

    def row_fn(args):
        r, q_row = args
        r0 = jnp.clip(r - kr // 2, 0, rows - kr)
        k_win = lax.dynamic_slice_in_dim(kg, r0, kr, axis=1)[:, :, col_idx]
        v_win = lax.dynamic_slice_in_dim(vg, r0, kr, axis=1)[:, :, col_idx]
        dr = r0 + jnp.arange(kr) - r + (NA_KR_MAX - 1)
        bias = rpb[:, dr[None, :, None], dc[:, None, :]]
        s_win = jnp.einsum('bqhd,baqchd->bhqac', q_row, k_win) * scale + bias
        s_ctx = jnp.einsum('bqhd,bkhd->bhqk', q_row, k_ctx) * scale
        logits = jnp.concatenate([s_win.reshape(b, nh, GRID_W, kr * NA_KC), s_ctx], axis=-1)
        p = softmax_f32(logits, v.dtype)
        p_win = p[..., :kr * NA_KC].reshape(b, nh, GRID_W, kr, NA_KC)
        p_ctx = p[..., kr * NA_KC:]
        return (jnp.einsum('bhqac,baqchd->bqhd', p_win, v_win)
                + jnp.einsum('bhqk,bkhd->bqhd', p_ctx, v_ctx))

    out = lax.map(row_fn, (jnp.arange(rows), qg.transpose(1, 0, 2, 3, 4)))
    return out.transpose(1, 0, 2, 3, 4).reshape(b, n, nh, d)


def mixer_na(h, w_qkv, w_out, rpb, ctx):
    b, n, _ = h.shape
    q, k, v = [a.reshape(b, n, N_NA, HEAD_DIM) for a in jnp.split(h @ w_qkv, 3, axis=-1)]
    if ctx is None:
        y = attend(q[:, :, :, None, :], k, v)
        aux = (k, v)
    else:
        y = neighbourhood_attention(q, k, v, ctx[0], ctx[1], rpb)
        aux = None
    return y.reshape(b, n, NA_W) @ w_out, aux


def setup_inputs(seed: int = 0) -> dict:
    key = jax.random.key(seed)
    ks = jax.random.split(key, 26)

    def nrm(i, shape, scale):
        return jax.random.normal(ks[i], shape, jnp.float32) * scale

    D = D_MODEL
    decay_logit = jnp.log(2.0 ** (5.0 + jnp.arange(N_RET, dtype=jnp.float32)) - 1.0)
    return {
        'x_prompt': nrm(0, (BATCH, SEQ, D), 1.0),
        'x_sample': nrm(1, (DEC_BATCH, DEC_SEQ, D), 1.0),
        'cache_gqa_k': nrm(2, (DEC_BATCH, N_EVEN, PAST_LEN, N_KV, HEAD_DIM), 1.0),
        'cache_gqa_v': nrm(3, (DEC_BATCH, N_EVEN, PAST_LEN, N_KV, HEAD_DIM), 1.0),
        'state_ret_fwd': nrm(4, (DEC_BATCH, N_EVEN, N_RET, RET_DK, RET_DV), 0.5),
        'state_ret_bwd': nrm(5, (DEC_BATCH, N_EVEN, N_RET, RET_DK, RET_DV), 0.5),
        'cache_na_k': nrm(6, (DEC_BATCH, N_ODD, PAST_LEN, N_NA, HEAD_DIM), 1.0),
        'cache_na_v': nrm(7, (DEC_BATCH, N_ODD, PAST_LEN, N_NA, HEAD_DIM), 1.0),
        'c': nrm(8, (DEC_BATCH, D), 1.0),
        'c_ctx': nrm(9, (D,), 1.0),
        'mod_w': nrm(10, (DEPTH, D, 3 * N_SUB * D), 0.5 * D ** -0.5),
        'mod_b': nrm(11, (DEPTH, 3 * N_SUB * D), 0.02),
        'norm_pre': 1.0 + nrm(12, (DEPTH, N_SUB, D), 0.02),
        'norm_post': 1.0 + nrm(13, (DEPTH, N_SUB, D), 0.02),
        'ffn_w_in': nrm(14, (DEPTH, 2, D, 2 * D_FF), D ** -0.5),
        'ffn_w_out': nrm(15, (DEPTH, 2, D_FF, D), D_FF ** -0.5),
        'ab_w_in': nrm(16, (N_EVEN, D, AB_IN), D ** -0.5),
        'ab_w_out': nrm(17, (N_EVEN, AB_OUT, D), AB_OUT ** -0.5),
        'ret_decay_fwd': decay_logit[None, :] + nrm(18, (N_EVEN, N_RET), 0.1),
        'ret_decay_bwd': decay_logit[None, :] + nrm(19, (N_EVEN, N_RET), 0.1),
        'ret_gn': 1.0 + nrm(20, (N_EVEN, RET_VW), 0.02),
        'gqa_q_norm': 1.0 + nrm(21, (N_EVEN, HEAD_DIM), 0.02),
        'gqa_k_norm': 1.0 + nrm(22, (N_EVEN, HEAD_DIM), 0.02),
        'na_w_qkv': nrm(23, (N_ODD, D, 3 * NA_W), D ** -0.5),
        'na_w_out': nrm(24, (N_ODD, NA_W, D), NA_W ** -0.5),
        'na_rpb': nrm(25, (N_ODD, N_NA, 2 * NA_KR_MAX - 1, 2 * NA_KC - 1), 0.1),
    }


def reference(x_prompt, x_sample, cache_gqa_k, cache_gqa_v, state_ret_fwd, state_ret_bwd, cache_na_k,
              cache_na_v, c, c_ctx, mod_w, mod_b, norm_pre, norm_post, ffn_w_in, ffn_w_out, ab_w_in,
              ab_w_out, ret_decay_fwd, ret_decay_bwd, ret_gn, gqa_q_norm, gqa_k_norm, na_w_qkv, na_w_out,
              na_rpb):

    def trunk(x, cond, ctx_layers):
        aux_out = []
        for l in range(DEPTH):
            mod = (jax.nn.silu(cond) @ mod_w[l] + mod_b[l]).reshape(cond.shape[0], 3 * N_SUB, D_MODEL)
            ctx = None if ctx_layers is None else ctx_layers[l]
            i = l // 2
            ffn1 = lambda h, l=l: (swiglu(h, ffn_w_in[l, 0], ffn_w_out[l, 0]), None)
            ffn2 = lambda h, l=l: (swiglu(h, ffn_w_in[l, 1], ffn_w_out[l, 1]), None)
            if l % 2 == 0:
                mix = lambda h, i=i, ctx=ctx: mixer_ab(h, ab_w_in[i], ab_w_out[i], ret_decay_fwd[i],
                                                       ret_decay_bwd[i], ret_gn[i], gqa_q_norm[i],
                                                       gqa_k_norm[i], ctx)
            else:
                mix = lambda h, i=i, ctx=ctx: mixer_na(h, na_w_qkv[i], na_w_out[i], na_rpb[i], ctx)
            x, _ = adaln_sublayer(x, mod, 0, norm_pre[l, 0], norm_post[l, 0], ffn1, 0.5)
            x, aux = adaln_sublayer(x, mod, 1, norm_pre[l, 1], norm_post[l, 1], mix, 1.0)
            x, _ = adaln_sublayer(x, mod, 2, norm_pre[l, 2], norm_post[l, 2], ffn2, 0.5)
            aux_out.append(aux)
        return x, aux_out

    y_prompt, ctx_aux = trunk(x_prompt, c_ctx[None, :], None)

    ctx_layers = []
    for l in range(DEPTH):
        i = l // 2
        if l % 2 == 0:
            ctx_layers.append((cache_gqa_k[:, i], cache_gqa_v[:, i], state_ret_fwd[:, i], state_ret_bwd[:, i]))
        else:
            ctx_layers.append((cache_na_k[:, i], cache_na_v[:, i]))
    y_sample, _ = trunk(x_sample, c, ctx_layers)

    new_gqa_k = jnp.stack([ctx_aux[l][0] for l in range(0, DEPTH, 2)], axis=1)
    new_gqa_v = jnp.stack([ctx_aux[l][1] for l in range(0, DEPTH, 2)], axis=1)
    new_ret_fwd = jnp.stack([ctx_aux[l][2] for l in range(0, DEPTH, 2)], axis=1)
    new_ret_bwd = jnp.stack([ctx_aux[l][3] for l in range(0, DEPTH, 2)], axis=1)
    new_na_k = jnp.stack([ctx_aux[l][0] for l in range(1, DEPTH, 2)], axis=1)
    new_na_v = jnp.stack([ctx_aux[l][1] for l in range(1, DEPTH, 2)], axis=1)
    return (y_prompt, y_sample, new_gqa_k, new_gqa_v, new_ret_fwd, new_ret_bwd, new_na_k, new_na_v)
```

```cpp
#include <hip/hip_runtime.h>
#include <hip/hip_cooperative_groups.h>
#include <cstdio>
#include <cstdint>
namespace cg = cooperative_groups;

#define LAS __attribute__((address_space(3)))
#define DI __device__ __forceinline__
typedef unsigned short bf16_t;
typedef short bf16x8 __attribute__((ext_vector_type(8)));
typedef float f32x4 __attribute__((ext_vector_type(4)));
typedef float f32x2 __attribute__((ext_vector_type(2)));
typedef float f32x16 __attribute__((ext_vector_type(16)));
typedef unsigned u32x4 __attribute__((ext_vector_type(4)));
typedef unsigned u32x2 __attribute__((ext_vector_type(2)));
typedef __bf16 bf16x2_t __attribute__((ext_vector_type(2)));

#ifndef PROBE
#define PROBE 0
#endif
constexpr int T = 40960, TC = 8192, D = 1024, DFF = 2816;
constexpr int LDS_BYTES = 131072 + 16;
constexpr float LOG2E = 1.4426950408889634f;
constexpr size_t O_GK = 41943040, O_GV = 42991616, O_RF = 44040192, O_RB = 45088768, O_NK = 46137344, O_NV = 54525952;
constexpr size_t WS_MOD = 0;
constexpr size_t WS_CTL = 786432;
constexpr size_t WS_W = 1048576;
constexpr size_t SZ_FIN = (size_t)5632 * 1024 * 2, SZ_FOUT = (size_t)1024 * 2816 * 2;
constexpr size_t WS_FIN = WS_W;
constexpr size_t WS_FOUT = WS_FIN + 4 * SZ_FIN;
constexpr size_t WS_ABIN = WS_FOUT + 4 * SZ_FOUT;
constexpr size_t WS_ABOUT = WS_ABIN + (size_t)2816 * 1024 * 2;
constexpr size_t WS_NAQKV = WS_ABOUT + (size_t)1024 * 1024 * 2;
constexpr size_t WS_NAOUT = WS_NAQKV + (size_t)3072 * 1024 * 2;
constexpr size_t WS_RA = WS_NAOUT + (size_t)1024 * 1024 * 2;
constexpr size_t SZ_H = (size_t)T * 1024 * 2;
constexpr size_t WS_H = WS_RA, WS_Y = WS_RA + SZ_H;
constexpr size_t WS_RB = WS_RA + 2 * SZ_H;
constexpr size_t WS_END = WS_RB + (size_t)T * 3072 * 2;
constexpr size_t RA_RKT = 0, RA_RVT = 41943040, RA_GKC = 83886080, RA_GKS = 85983232, RA_GVTC = 94896128, RA_GVTS = 96993280,
                 RA_KVS = 105906176, RA_FB = 139460608;
constexpr size_t RA_NVT = 0, RA_NKC = 83886080, RA_NVTC = 88080384;

DI unsigned pk2(float lo, float hi) { bf16x2_t v = __builtin_convertvector((f32x2){lo, hi}, bf16x2_t); return __builtin_bit_cast(unsigned, v); }
DI bf16_t f2bf(float f) { return (bf16_t)(pk2(f, 0.f) & 0xffffu); }
DI float bf2f(unsigned short b) { return __uint_as_float(((unsigned)b) << 16); }
DI float bflo(unsigned u) { return __uint_as_float(u << 16); }
DI float bfhi(unsigned u) { return __uint_as_float(u & 0xffff0000u); }
DI float wave_sum(float v) {
#pragma unroll
    for (int o = 32; o >= 1; o >>= 1) v += __shfl_xor(v, o);
    return v;
}
DI float fexp2(float x) { return __builtin_amdgcn_exp2f(x); }
DI float silu_f(float g) { return g * __builtin_amdgcn_rcpf(1.f + fexp2(-LOG2E * g)); }
#define LDS_WAIT() asm volatile("s_waitcnt lgkmcnt(0)" ::: "memory")
#define MFMA32(a, b, c) __builtin_amdgcn_mfma_f32_32x32x16_bf16((a), (b), (c), 0, 0, 0)
DI int otid() { int t = threadIdx.x; asm volatile("" : "+v"(t)); return t; }
DI int crow(int i, int h) { return (i & 3) + 8 * (i >> 2) + 4 * h; }


#define XB_TMO      128
#define XB_XCNT(j)  (256  + 64 * (j))
#define XB_XSUB(j)  (1280 + 64 * (j))
#define XB_XGEN(j)  (2304 + 64 * (j))
#define XB_TOP      3328
#define XB_TOPGEN   3392
#define XCD_BAR_WORDS 3456
#define XB_SPIN_CAP (1u << 22)
DI unsigned xb_ld(unsigned* p)              { return __hip_atomic_load(p, __ATOMIC_RELAXED, __HIP_MEMORY_SCOPE_AGENT); }
DI unsigned xb_add(unsigned* p, unsigned v) { return __hip_atomic_fetch_add(p, v, __ATOMIC_RELAXED, __HIP_MEMORY_SCOPE_AGENT); }
DI unsigned xb_xcc_id() { return (unsigned)__builtin_amdgcn_s_getreg((3 << 11) | 20) & 0xFu; }
#define XB_SPIN(cond, bar) do { unsigned _sp = 0; while (cond) { __builtin_amdgcn_s_sleep(1); \
    if ((++_sp & 255u) == 0u) { if (xb_ld(&(bar)[XB_TMO])) break; if (_sp > XB_SPIN_CAP) { atomicAdd(&(bar)[XB_TMO], 1u); break; } } } } while (0)
struct XcdBarrier { unsigned* bar; unsigned x; volatile LAS unsigned* st; };
DI XcdBarrier xcd_barrier_post(unsigned* bar, volatile LAS unsigned* st) {
    XcdBarrier b; b.bar = bar; b.x = xb_xcc_id(); b.st = st;
    if (threadIdx.x == 0) (void)xb_add(&bar[XB_XCNT(b.x)], 1u);
    return b;
}
DI void xcd_barrier_complete(unsigned* bar, unsigned x, unsigned& nloc, unsigned& nx) {
    const unsigned G = gridDim.x * gridDim.y * gridDim.z;
    unsigned sum, cnt, mine, sp = 0u;
    for (;;) {
        sum = 0u; cnt = 0u; mine = 0u;
#pragma unroll
        for (unsigned j = 0; j < 16; ++j) { const unsigned c = xb_ld(&bar[XB_XCNT(j)]); sum += c; cnt += (c > 0u) ? 1u : 0u; mine = (j == x) ? c : mine; }
        if (sum == G) break;
        __builtin_amdgcn_s_sleep(1);
        if ((++sp & 255u) == 0u) { if (xb_ld(&bar[XB_TMO])) break; if (sp > XB_SPIN_CAP) { atomicAdd(&bar[XB_TMO], 1u); break; } }
    }
    nloc = mine > 0u ? mine : 1u; nx = cnt > 0u ? cnt : 1u;
}
DI void xcd_barrier(const XcdBarrier& b) {
    asm volatile("s_waitcnt vmcnt(0)" ::: "memory");
    __syncthreads();
    if (threadIdx.x == 0) {
        unsigned* bar = b.bar;
        __builtin_amdgcn_s_waitcnt(0);
        unsigned nloc = b.st[0], nx = b.st[1];
        if (nloc == 0u) { xcd_barrier_complete(bar, b.x, nloc, nx); b.st[0] = nloc; b.st[1] = nx; }
        const unsigned old = xb_add(&bar[XB_XSUB(b.x)], 1u);
        const unsigned gen = old / nloc;
        if (old + 1u == (gen + 1u) * nloc) {
            __builtin_amdgcn_fence(__ATOMIC_RELEASE, "agent");
            asm volatile("s_waitcnt vmcnt(0)" ::: "memory");
            const unsigned og = xb_add(&bar[XB_TOP], 1u);
            const unsigned tg = og / nx;
            if (og + 1u == (tg + 1u) * nx) xb_add(&bar[XB_TOPGEN], 1u);
            else XB_SPIN(xb_ld(&bar[XB_TOPGEN]) == tg, bar);
            __builtin_amdgcn_fence(__ATOMIC_ACQUIRE, "agent");
            xb_add(&bar[XB_XGEN(b.x)], 1u);
            asm volatile("s_waitcnt vmcnt(0)" ::: "memory");
        } else {
            XB_SPIN(xb_ld(&bar[XB_XGEN(b.x)]) == gen, bar);
            __builtin_amdgcn_fence(__ATOMIC_ACQUIRE, "agent");
            asm volatile("s_waitcnt vmcnt(0)" ::: "memory");
        }
    }
    __syncthreads();
}

namespace g8 {
constexpr int BM = 256, BK = 64, HALF = 128, HTB = HALF * BK * 2, NXCD = 8, WGM = 4;
DI int lds_byte(int r, int c) { const int st = (r >> 4) * 2 + (c >> 5), rr = r & 15, cc = c & 31, ob = rr * 64 + cc * 2; return st * 1024 + (ob ^ (((ob >> 9) & 1) << 5)); }
DI void stage_rc(int b, int& R, int& C) { const int st = b / 1024, sb = b % 1024, swz = sb ^ (((sb >> 9) & 1) << 5); R = (st >> 1) * 16 + swz / 64; C = (st & 1) * 32 + (swz % 64) / 2; }
DI int perm32(int rho) { const int n = rho >> 4, i = rho & 15; return 8 * (i >> 2) + 4 * n + (i & 3); }
struct Unit { int pm, pn, kt0, nt, part; };
struct Gemm { const bf16_t* A; int lda; const bf16_t* Bt; int M, N, K; };
struct StaticOrder {
    int nM, nN, nwg, G, c, ntk;
    DI void init(int M, int N, int K, int G_, int c_) { nM = M / BM; nN = N / BM; nwg = nM * nN; G = G_; c = c_; ntk = K / BK; }
    DI bool next(int i, Unit& u) const {
        const long L = (long)i * G + c; if (L >= nwg) return false;
        int wgid = (int)L; { const int q = nwg / NXCD, r = nwg % NXCD, xcd = wgid % NXCD, off = wgid / NXCD; wgid = (xcd < r ? xcd * (q + 1) : r * (q + 1) + (xcd - r) * q) + off; }
        const int nig = WGM * nN, gid = wgid / nig, fm = gid * WGM, gsz = (nM - fm) < WGM ? (nM - fm) : WGM;
        u.pm = fm + ((wgid % nig) % gsz); u.pn = (wgid % nig) / gsz; u.kt0 = 0; u.nt = ntk; u.part = 0; return true;
    }
};
struct SplitOrder {
    int ntk, c;
    DI void init(int K, int c_) { ntk = K / BK; c = c_; }
    DI bool next(int i, Unit& u) const {
        const int xcd = c & 7, slot = c >> 3;
        if (i < 2) { const int L = i * 256 + xcd * 32 + slot; u.pm = L >> 2; u.pn = L & 3; u.kt0 = 0; u.nt = ntk; u.part = 0; return true; }
        if (i == 2) { const int L = 512 + xcd * 16 + (slot >> 1), hf = slot & 1; u.pm = L >> 2; u.pn = L & 3; u.kt0 = hf * (ntk >> 1); u.nt = ntk >> 1; u.part = hf; return true; }
        return false;
    }
};
struct EpiBf16 {
    bf16_t* O; int ldc; bf16_t* O2 = nullptr;
    DI void operator()(const f32x4 (&acc)[2][2][4][2], const Unit& u, int wr, int wc, int fr, int fq) const {
        const int row0 = u.pm * BM + wr * 64 + fr, col0 = u.pn * BM + wc * 32 + 8 * fq;
#pragma unroll
        for (int ai = 0; ai < 2; ++ai)
#pragma unroll
            for (int m = 0; m < 4; ++m) { bf16_t* rowp = (u.part ? O2 - (size_t)32768 * ldc : O) + (size_t)(row0 + ai * HALF + m * 16) * ldc + col0;
#pragma unroll
                for (int bj = 0; bj < 2; ++bj) { const f32x4 v0 = acc[ai][bj][m][0], v1 = acc[ai][bj][m][1];
                    u32x4 w; w.x = pk2(v0[0], v0[1]); w.y = pk2(v0[2], v0[3]); w.z = pk2(v1[0], v1[1]); w.w = pk2(v1[2], v1[3]);
                    *(u32x4*)(rowp + bj * HALF) = w; } }
    }
};
struct EpiSwiGLU {
    bf16_t* O;
    DI void operator()(const f32x4 (&acc)[2][2][4][2], const Unit& u, int wr, int wc, int fr, int fq) const {
        const int row0 = u.pm * BM + wr * 64 + fr, col0 = u.pn * HALF + wc * 32 + 8 * fq;
#pragma unroll
        for (int ai = 0; ai < 2; ++ai)
#pragma unroll
            for (int m = 0; m < 4; ++m) { bf16_t* rowp = O + (size_t)(row0 + ai * HALF + m * 16) * DFF + col0;
                float r[8];
#pragma unroll
                for (int n = 0; n < 2; ++n)
#pragma unroll
                    for (int j = 0; j < 4; ++j) { const float g = acc[ai][0][m][n][j], up = acc[ai][1][m][n][j]; r[4 * n + j] = silu_f(g) * up; }
                u32x4 w; w.x = pk2(r[0], r[1]); w.y = pk2(r[2], r[3]); w.z = pk2(r[4], r[5]); w.w = pk2(r[6], r[7]);
                *(u32x4*)rowp = w; }
    }
};

template <class Epi, class Order>
DI void gemm_phase(LAS unsigned char* lds, const Gemm g, const Order& S, const Epi& E) {
    const int tid = otid(), wid = __builtin_amdgcn_readfirstlane(tid >> 6), lane = tid & 63, wr = wid >> 2, wc = wid & 3, fr = lane & 15, fq = lane >> 4;
    const int K = g.K, lda = g.lda;
    unsigned voffA[2], voffB[2];
#pragma unroll
    for (int i = 0; i < 2; ++i) { int R, C; stage_rc(tid * 16 + i * 8192, R, C); const int Rb = (R & ~31) + perm32(R & 31);
        voffA[i] = (unsigned)(R * lda + C) * 2u; voffB[i] = (unsigned)(Rb * K + C) * 2u; }
    const size_t kstep = (size_t)(BK * 2);
    const size_t hstepA = (size_t)HALF * lda * 2, hstepB = (size_t)HALF * K * 2;
    const size_t tstepA = 2 * hstepA, tstepB = 2 * hstepB;
    const unsigned ldsw = (unsigned)wid * 1024u;
    const int aoff = lds_byte(wr * 64 + fr, fq * 8), boff = lds_byte(wc * 32 + fr, fq * 8);
#define G8_SA(b, h) (((b) * 2 + (h)) * HTB)
#define G8_SB(b, h) ((4 + (b) * 2 + (h)) * HTB)
#define G8_STAGE(bufoff, gbase, voff) do { _Pragma("unroll") for (int _i = 0; _i < 2; ++_i) \
        __builtin_amdgcn_global_load_lds((const unsigned*)((const char*)(gbase) + (voff)[_i]), (LAS unsigned*)(lds + (bufoff) + ldsw + _i * 8192), 16, 0, 0); } while (0)
#define G8_LDA(dst, b, h) do { _Pragma("unroll") for (int m = 0; m < 4; ++m) _Pragma("unroll") for (int k = 0; k < 2; ++k) dst[m][k] = *(const LAS bf16x8*)(lds + G8_SA(b, h) + aoff + m * 2048 + k * 1024); } while (0)
#define G8_LDB(dst, b, h) do { _Pragma("unroll") for (int n = 0; n < 2; ++n) _Pragma("unroll") for (int k = 0; k < 2; ++k) dst[n][k] = *(const LAS bf16x8*)(lds + G8_SB(b, h) + boff + n * 2048 + k * 1024); } while (0)
#define G8_MMA(ai, bj, At, Bt) do { __builtin_amdgcn_s_setprio(1); _Pragma("unroll") for (int m = 0; m < 4; ++m) _Pragma("unroll") for (int n = 0; n < 2; ++n) _Pragma("unroll") for (int k = 0; k < 2; ++k) \
        acc[ai][bj][m][n] = __builtin_amdgcn_mfma_f32_16x16x32_bf16(Bt[n][k], At[m][k], acc[ai][bj][m][n], 0, 0, 0); __builtin_amdgcn_s_setprio(0); } while (0)
#define G8_WAIT_V(n) asm volatile("s_waitcnt vmcnt(" #n ")" ::: "memory")
#define G8_WAIT_L(n) asm volatile("s_waitcnt lgkmcnt(" #n ")" ::: "memory")
#define G8_BAR __builtin_amdgcn_s_barrier()
#define G8_SCHED __builtin_amdgcn_sched_barrier(0)
    Unit cur, nxt; int ui = 0;
    if (!S.next(0, cur)) return;
    f32x4 acc[2][2][4][2];
#pragma unroll
    for (int a = 0; a < 2; ++a)
#pragma unroll
        for (int b = 0; b < 2; ++b)
#pragma unroll
            for (int m = 0; m < 4; ++m)
#pragma unroll
                for (int n = 0; n < 2; ++n) acc[a][b][m][n] = (f32x4){0.f, 0.f, 0.f, 0.f};
    bf16x8 At[4][2], B0[2][2], B1[2][2];
    const char* cA = (const char*)g.A + (size_t)cur.pm * tstepA + (size_t)cur.kt0 * kstep; const char* cB = (const char*)g.Bt + (size_t)cur.pn * tstepB + (size_t)cur.kt0 * kstep;
    G8_STAGE(G8_SB(0, 0), cB, voffB); G8_STAGE(G8_SB(0, 1), cB + hstepB, voffB); G8_STAGE(G8_SA(0, 0), cA, voffA); G8_STAGE(G8_SA(0, 1), cA + hstepA, voffA);
    if (wr == 1) G8_BAR;
    G8_WAIT_V(2); G8_BAR;
    G8_STAGE(G8_SB(1, 0), cB + kstep, voffB); G8_STAGE(G8_SA(1, 0), cA + kstep, voffA); G8_STAGE(G8_SB(1, 1), cB + hstepB + kstep, voffB);
    G8_WAIT_V(6); G8_BAR;
    for (;;) {
        const bool has_next = S.next(ui + 1, nxt);
        const char* nA = has_next ? (const char*)g.A + (size_t)nxt.pm * tstepA + (size_t)nxt.kt0 * kstep : cA; const char* nB = has_next ? (const char*)g.Bt + (size_t)nxt.pn * tstepB + (size_t)nxt.kt0 * kstep : cB;
        const int nt = cur.nt;
        for (int t = 0; t < nt; t += 2) {
            const bool last = (t == nt - 2);
            const char* a1 = cA + (size_t)(t + 1) * kstep;
            const char* a2 = last ? nA : cA + (size_t)(t + 2) * kstep; const char* b2 = last ? nB : cB + (size_t)(t + 2) * kstep;
            const char* a3 = a2 + kstep; const char* b3 = b2 + kstep;
            G8_LDB(B0, 0, 0); G8_LDB(B1, 0, 1); G8_SCHED; G8_LDA(At, 0, 0); G8_STAGE(G8_SA(1, 1), a1 + hstepA, voffA);
            G8_WAIT_V(8); G8_WAIT_L(0); G8_BAR; G8_MMA(0, 0, At, B0); G8_MMA(0, 1, At, B1); G8_BAR; G8_SCHED;
            G8_LDA(At, 0, 1); G8_STAGE(G8_SB(0, 0), b2, voffB); G8_STAGE(G8_SB(0, 1), b2 + hstepB, voffB); G8_STAGE(G8_SA(0, 0), a2, voffA);
            G8_WAIT_V(8); G8_WAIT_L(0); G8_BAR; G8_MMA(1, 0, At, B0); G8_MMA(1, 1, At, B1); G8_BAR; G8_SCHED;
            G8_LDB(B0, 1, 0); G8_LDB(B1, 1, 1); G8_SCHED; G8_LDA(At, 1, 0); G8_STAGE(G8_SA(0, 1), a2 + hstepA, voffA);
            G8_WAIT_V(8); G8_WAIT_L(0); G8_BAR; G8_MMA(0, 0, At, B0); G8_MMA(0, 1, At, B1); G8_BAR; G8_SCHED;
            G8_LDA(At, 1, 1); G8_STAGE(G8_SB(1, 0), b3, voffB); G8_STAGE(G8_SB(1, 1), b3 + hstepB, voffB); G8_STAGE(G8_SA(1, 0), a3, voffA);
            G8_WAIT_V(8); G8_WAIT_L(0); G8_BAR; G8_MMA(1, 0, At, B0); G8_MMA(1, 1, At, B1); G8_BAR; G8_SCHED;
        }
        if (wr == 0) G8_BAR;
        E(acc, cur, wr, wc, fr, fq);
        if (!has_next) break;
#pragma unroll
        for (int a = 0; a < 2; ++a)
#pragma unroll
            for (int b = 0; b < 2; ++b)
#pragma unroll
                for (int m = 0; m < 4; ++m)
#pragma unroll
                    for (int n = 0; n < 2; ++n) acc[a][b][m][n] = (f32x4){0.f, 0.f, 0.f, 0.f};
        cur = nxt; cA = nA; cB = nB; ++ui;
        if (wr == 1) G8_BAR;
    }
    G8_WAIT_V(0);
    G8_BAR;
}
}

DI void phase_mod(const float* c, const float* c_ctx, const float* mod_w, const float* mod_b, float* mod, LAS float* lds) {
    const int tid = otid(), lane = tid & 63, wave = tid >> 6;
    LAS float* sc = lds;
    LAS float* red = lds + 9 * 1024;
    for (int idx = tid; idx < 9 * 1024; idx += 512) { const int ci = idx >> 10, k = idx & 1023; const float v = (ci == 0) ? c_ctx[k] : c[(ci - 1) * 1024 + k]; sc[idx] = silu_f(v); }
    __syncthreads();
    for (int item = blockIdx.x; item < 2 * 144; item += gridDim.x) {
        const int l = item / 144, j = (item % 144) * 64 + lane;
        float a0 = 0, a1 = 0, a2 = 0, a3 = 0, a4 = 0, a5 = 0, a6 = 0, a7 = 0, a8 = 0;
        const float* wp = mod_w + ((size_t)l * 1024 + wave * 128) * 9216 + j;
        LAS const float* sp = sc + wave * 128;
#pragma unroll 32
        for (int k = 0; k < 128; ++k) { const float w = wp[(size_t)k * 9216];
            a0 += sp[k] * w; a1 += sp[1024 + k] * w; a2 += sp[2048 + k] * w; a3 += sp[3072 + k] * w; a4 += sp[4096 + k] * w;
            a5 += sp[5120 + k] * w; a6 += sp[6144 + k] * w; a7 += sp[7168 + k] * w; a8 += sp[8192 + k] * w; }
        LAS float* rp = red + wave * 576 + lane;
        rp[0] = a0; rp[64] = a1; rp[128] = a2; rp[192] = a3; rp[256] = a4; rp[320] = a5; rp[384] = a6; rp[448] = a7; rp[512] = a8;
        __syncthreads();
        for (int e = tid; e < 576; e += 512) { float s = 0.f;
#pragma unroll
            for (int w2 = 0; w2 < 8; ++w2) s += red[w2 * 576 + e];
            const int ci = e >> 6, jj = (item % 144) * 64 + (e & 63);
            mod[((size_t)l * 9 + ci) * 9216 + jj] = s + mod_b[(size_t)l * 9216 + jj]; }
        __syncthreads();
    }
}
struct WItem { const float* W; bf16_t* WT; int K, N, mode, item; float qs; };
DI void witem_load(const WItem& d, f32x4 (&v)[8], int lane) {
    const int nblk = d.N / 32, kb = d.item / nblk, nb = d.item % nblk, k0 = 64 * kb, n0 = 32 * nb;
    const int lr = lane >> 3, c4 = (lane & 7) * 4;
#pragma unroll
    for (int i = 0; i < 8; ++i) v[i] = __builtin_nontemporal_load((const f32x4*)(d.W + (size_t)(k0 + 8 * i + lr) * d.N + n0 + c4));
}
DI void witem_finish(const WItem& d, const f32x4 (&v)[8], LAS float* scr, int lane) {
    const int nblk = d.N / 32, kb = d.item / nblk, nb = d.item % nblk, k0 = 64 * kb, n0 = 32 * nb;
    const int lr = lane >> 3, c4 = (lane & 7) * 4;
    const float cs = (n0 < 1024) ? d.qs : 1.f;
#pragma unroll
    for (int i = 0; i < 8; ++i) { LAS float* s = scr + (8 * i + lr) * 33 + c4; s[0] = v[i].x * cs; s[1] = v[i].y * cs; s[2] = v[i].z * cs; s[3] = v[i].w * cs; }
    LDS_WAIT();
    int d0 = n0;
    if (d.mode == 1) { const int bj = n0 / DFF, rem = n0 % DFF; d0 = 256 * (rem / 128) + 128 * bj + (rem % 128); }
    const int c = lane & 7;
#pragma unroll
    for (int j = 0; j < 4; ++j) { const int n = (lane >> 3) + 8 * j; LAS const float* s = scr + (8 * c) * 33 + n;
        u32x4 o; o.x = pk2(s[0 * 33], s[1 * 33]); o.y = pk2(s[2 * 33], s[3 * 33]); o.z = pk2(s[4 * 33], s[5 * 33]); o.w = pk2(s[6 * 33], s[7 * 33]);
        *(u32x4*)(d.WT + (size_t)(d0 + n) * d.K + k0 + 8 * c) = o; }
    LDS_WAIT();
}
struct Params { const float* in[26]; float* out; unsigned char* ws; };

DI WItem witem_of(const Params& p, int it) {
    constexpr int I_FIN = 16 * 176, I_FOUT = 44 * 32, I_ABIN = 16 * 88, I_ABOUT = 16 * 32, I_NAQKV = 16 * 96;
    WItem d; d.qs = 1.f; d.mode = 0;
    int r = it;
    if (r < 4 * I_FIN) { const int mi = r / I_FIN; d.W = p.in[14] + (size_t)mi * 1024 * 5632; d.K = 1024; d.N = 5632; d.WT = (bf16_t*)(p.ws + WS_FIN + mi * SZ_FIN); d.mode = 1; d.item = r % I_FIN; return d; } r -= 4 * I_FIN;
    if (r < 4 * I_FOUT) { const int mi = r / I_FOUT; d.W = p.in[15] + (size_t)mi * 2816 * 1024; d.K = 2816; d.N = 1024; d.WT = (bf16_t*)(p.ws + WS_FOUT + mi * SZ_FOUT); d.item = r % I_FOUT; return d; } r -= 4 * I_FOUT;
    if (r < I_ABIN) { d.W = p.in[16]; d.K = 1024; d.N = 2816; d.WT = (bf16_t*)(p.ws + WS_ABIN); d.item = r; return d; } r -= I_ABIN;
    if (r < I_ABOUT) { d.W = p.in[17]; d.K = 1024; d.N = 1024; d.WT = (bf16_t*)(p.ws + WS_ABOUT); d.item = r; return d; } r -= I_ABOUT;
    if (r < I_NAQKV) { d.W = p.in[23]; d.K = 1024; d.N = 3072; d.WT = (bf16_t*)(p.ws + WS_NAQKV); d.item = r; d.qs = 0.125f * LOG2E; return d; } r -= I_NAQKV;
    d.W = p.in[24]; d.K = 1024; d.N = 1024; d.WT = (bf16_t*)(p.ws + WS_NAOUT); d.item = r; return d;
}
DI void phase_weights(const Params& p, LAS unsigned char* lds) {
    const int tid = otid(), lane = tid & 63, wave = tid >> 6;
    LAS float* scr = (LAS float*)(lds + 57344 + wave * 8704);
    const int gw = blockIdx.x * 8 + wave, NGW = gridDim.x * 8;
    constexpr int NITEMS = 4 * (16 * 176) + 4 * (44 * 32) + 16 * 88 + 16 * 32 + 16 * 96 + 16 * 32;
    for (int it = gw; it < NITEMS; it += 2 * NGW) {
        const int it2 = it + NGW; const bool has2 = it2 < NITEMS;
        const WItem dA = witem_of(p, it); const WItem dB = witem_of(p, has2 ? it2 : it);
        f32x4 vA[8], vB[8];
        witem_load(dA, vA, lane);
        if (has2) witem_load(dB, vB, lane);
        witem_finish(dA, vA, scr, lane);
        if (has2) witem_finish(dB, vB, scr, lane);
    }
}

template <bool HAS_Y, bool HAS_H, bool DUMMY = false, bool STORE_X = true>
DI void row_phase(const float* x0, const float* x1, float* X, const bf16_t* Y, const bf16_t* Y2, bf16_t* H,
                  const float* modg, int sg, float wgt, const float* gpost, const float* modn, int sn, const float* gpre) {
    const int tid = otid(), lane = tid & 63, gw = blockIdx.x * 8 + (tid >> 6), NGW = gridDim.x * 8;
    for (int tA = gw; tA < T; tA += 2 * NGW) {
        const int tB = tA + NGW; const bool hasB = tB < T;
        f32x4 vA[4], vB[4]; u32x2 yA[4], yB[4], zA[4], zB[4];
#define ROW_LOAD(t, v, yr, zr) do { const float* xr = ((t) < TC) ? x0 + (size_t)(t) * 1024 : x1 + (size_t)((t) - TC) * 1024; \
        _Pragma("unroll") for (int j = 0; j < 4; ++j) v[j] = __builtin_nontemporal_load((const f32x4*)(xr + 4 * lane + 256 * j)); \
        if (HAS_Y) { _Pragma("unroll") for (int j = 0; j < 4; ++j) { yr[j] = *(const u32x2*)(Y + (size_t)(t) * 1024 + 4 * lane + 256 * j); \
            zr[j] = ((t) >= 32768) ? *(const u32x2*)(Y2 + (size_t)((t) - 32768) * 1024 + 4 * lane + 256 * j) : (u32x2){0u, 0u}; } } } while (0)
        ROW_LOAD(tA, vA, yA, zA);
        if (hasB) ROW_LOAD(tB, vB, yB, zB);
#undef ROW_LOAD
#define ROW_COMPUTE(t, v, yr, zr) do { \
        const int ci = (t) < TC ? 0 : 1 + (((t) - TC) >> 12); \
        if (HAS_Y) { f32x4 y[4]; float ss = 0.f; \
            _Pragma("unroll") for (int j = 0; j < 4; ++j) { \
                y[j] = (f32x4){bflo(yr[j].x) + bflo(zr[j].x), bfhi(yr[j].x) + bfhi(zr[j].x), bflo(yr[j].y) + bflo(zr[j].y), bfhi(yr[j].y) + bfhi(zr[j].y)}; \
                ss += (y[j].x * y[j].x + y[j].y * y[j].y) + (y[j].z * y[j].z + y[j].w * y[j].w); } \
            ss = wave_sum(ss); \
            const float r = rsqrtf(ss * (1.f / 1024.f) + 1e-6f) * wgt; \
            const float* gate = modg + (size_t)ci * 9216 + sg * 1024; \
            _Pragma("unroll") for (int j = 0; j < 4; ++j) { const f32x4 g = *(const f32x4*)(gate + 4 * lane + 256 * j); const f32x4 gp = *(const f32x4*)(gpost + 4 * lane + 256 * j); \
                v[j] = v[j] + (g * gp) * (y[j] * r); } } \
        if (STORE_X) { float* xo = X + (size_t)(DUMMY ? ((t) & 63) : (t)) * 1024; \
            _Pragma("unroll") for (int j = 0; j < 4; ++j) __builtin_nontemporal_store(v[j], (f32x4*)(xo + 4 * lane + 256 * j)); } \
        if (HAS_H) { float ss = 0.f; \
            _Pragma("unroll") for (int j = 0; j < 4; ++j) ss += (v[j].x * v[j].x + v[j].y * v[j].y) + (v[j].z * v[j].z + v[j].w * v[j].w); \
            ss = wave_sum(ss); \
            const float r = rsqrtf(ss * (1.f / 1024.f) + 1e-6f); \
            const float* shift = modn + (size_t)ci * 9216 + sn * 1024; const float* scale = shift + 1024; \
            bf16_t* ho = H + (size_t)(DUMMY ? ((t) & 63) : (t)) * 1024; \
            _Pragma("unroll") for (int j = 0; j < 4; ++j) { const f32x4 sh = *(const f32x4*)(shift + 4 * lane + 256 * j), scl = *(const f32x4*)(scale + 4 * lane + 256 * j), gp = *(const f32x4*)(gpre + 4 * lane + 256 * j); \
                const f32x4 hv = (v[j] * r) * gp * (scl + 1.f) + sh; \
                u32x2 o; o.x = pk2(hv.x, hv.y); o.y = pk2(hv.z, hv.w); \
                *(u32x2*)(ho + 4 * lane + 256 * j) = o; } } } while (0)
        ROW_COMPUTE(tA, vA, yA, zA);
        if (hasB) ROW_COMPUTE(tB, vB, yB, zB);
#undef ROW_COMPUTE
    }
}

template <class SrcF>
DI void wave_transpose64(LAS unsigned short* scr, SrcF src, bf16_t* dst, size_t ldd, int lane) {
    const int lr = lane >> 3, ch = lane & 7;
    u32x4 v[8];
#pragma unroll
    for (int i = 0; i < 8; ++i) v[i] = src(8 * i + lr, ch);
#pragma unroll
    for (int i = 0; i < 8; ++i) { LAS unsigned* s = (LAS unsigned*)(scr + (8 * i + lr) * 66 + 8 * ch); s[0] = v[i].x; s[1] = v[i].y; s[2] = v[i].z; s[3] = v[i].w; }
    LDS_WAIT();
#pragma unroll
    for (int j = 0; j < 8; ++j) { const int d = lr + 8 * j; LAS const unsigned short* s = scr + (8 * ch) * 66 + d;
        u32x4 o;
        o.x = (unsigned)s[0 * 66] | ((unsigned)s[1 * 66] << 16); o.y = (unsigned)s[2 * 66] | ((unsigned)s[3 * 66] << 16);
        o.z = (unsigned)s[4 * 66] | ((unsigned)s[5 * 66] << 16); o.w = (unsigned)s[6 * 66] | ((unsigned)s[7 * 66] << 16);
        *(u32x4*)(dst + (size_t)d * ldd + 8 * ch) = o; }
    LDS_WAIT();
}
struct TItem { const void* src; size_t lds_; int f32; bf16_t* dst; size_t ldd; };
DI void titem_load(const TItem& d, u32x4 (&v)[8], int lane) {
    const int lr = lane >> 3, ch = lane & 7;
    if (d.f32) {
#pragma unroll
        for (int i = 0; i < 8; ++i) { const float* p = (const float*)d.src + (size_t)(8 * i + lr) * d.lds_ + 8 * ch; const f32x4 a = *(const f32x4*)p, b = *(const f32x4*)(p + 4);
            v[i].x = pk2(a.x, a.y); v[i].y = pk2(a.z, a.w); v[i].z = pk2(b.x, b.y); v[i].w = pk2(b.z, b.w); }
    } else {
#pragma unroll
        for (int i = 0; i < 8; ++i) v[i] = *(const u32x4*)((const bf16_t*)d.src + (size_t)(8 * i + lr) * d.lds_ + 8 * ch);
    }
}
DI void titem_finish(const TItem& d, const u32x4 (&v)[8], LAS unsigned short* scr, int lane) {
    const int lr = lane >> 3, ch = lane & 7;
#pragma unroll
    for (int i = 0; i < 8; ++i) { LAS unsigned* s = (LAS unsigned*)(scr + (8 * i + lr) * 66 + 8 * ch); s[0] = v[i].x; s[1] = v[i].y; s[2] = v[i].z; s[3] = v[i].w; }
    LDS_WAIT();
#pragma unroll
    for (int j = 0; j < 8; ++j) { const int dd = lr + 8 * j; LAS const unsigned short* s = scr + (8 * ch) * 66 + dd;
        u32x4 o;
        o.x = (unsigned)s[0 * 66] | ((unsigned)s[1 * 66] << 16); o.y = (unsigned)s[2 * 66] | ((unsigned)s[3 * 66] << 16);
        o.z = (unsigned)s[4 * 66] | ((unsigned)s[5 * 66] << 16); o.w = (unsigned)s[6 * 66] | ((unsigned)s[7 * 66] << 16);
        *(u32x4*)(d.dst + (size_t)dd * d.ldd + 8 * ch) = o; }
    LDS_WAIT();
}
DI u32x4 ld8_bf16(const bf16_t* p) { return *(const u32x4*)p; }
DI u32x4 ld8_f32(const float* p) { const f32x4 a = *(const f32x4*)p, b = *(const f32x4*)(p + 4); u32x4 o; o.x = pk2(a.x, a.y); o.y = pk2(a.z, a.w); o.z = pk2(b.x, b.y); o.w = pk2(b.z, b.w); return o; }

DI void phase_prep0(const Params& p, LAS unsigned char* lds) {
    const int tid = otid(), lane = tid & 63, wave = tid >> 6;
    const int gw = blockIdx.x * 8 + wave, NGW = gridDim.x * 8;
    bf16_t* P = (bf16_t*)(p.ws + WS_RB);
    unsigned char* RA = p.ws + WS_RA;
    bf16_t* rKt = (bf16_t*)(RA + RA_RKT); bf16_t* rVt = (bf16_t*)(RA + RA_RVT);
    bf16_t* gKc = (bf16_t*)(RA + RA_GKC); bf16_t* gKs = (bf16_t*)(RA + RA_GKS);
    bf16_t* gVtc = (bf16_t*)(RA + RA_GVTC); bf16_t* gVts = (bf16_t*)(RA + RA_GVTS);
    LAS float* rt = (LAS float*)lds;
    for (int e = tid; e < 1024; e += 512) { const int pos = e >> 4, i = e & 15; const float inv = powf(10000.f, -(float)i / 16.f); const float ang = (float)pos * inv;
        rt[e] = cosf(ang); rt[1024 + e] = sinf(ang); }
    __syncthreads();
    LAS unsigned short* scr = (LAS unsigned short*)(lds + 16384 + wave * 8704);
    constexpr int NA_ = 640 * 8, NB_ = 640 * 8, NC_ = 128 * 2, ND_ = 512 * 2, NE_ = 64, NTOT_ = NA_ + NB_ + NC_ + ND_ + NE_;
    auto item_of = [&](int it) {
        TItem d; d.f32 = 0; d.lds_ = 2816;
        int r = it;
        if (r < NA_ + NB_) { const int isv = r >= NA_; if (isv) r -= NA_; const int tb = r >> 3, h = r & 7, t0 = 64 * tb;
            d.src = P + (size_t)t0 * 2816 + (isv ? 1024 : 512) + 64 * h; d.dst = (isv ? rVt : rKt) + (size_t)(64 * h) * T + t0; d.ldd = (size_t)T; return d; }
        r -= NA_ + NB_;
        if (r < NC_) { const int tb = r >> 1, kvh = r & 1, t0 = 64 * tb, b = t0 >> 8;
            d.src = P + (size_t)t0 * 2816 + 2688 + 64 * kvh; d.dst = gVtc + (size_t)(b * 128 + 64 * kvh) * 256 + (t0 & 255); d.ldd = 256; return d; }
        r -= NC_;
        if (r < ND_) { const int tb = r >> 1, kvh = r & 1, n0g = 64 * tb, b = n0g >> 12, n0 = n0g & 4095;
            d.src = P + (size_t)(TC + n0g) * 2816 + 2688 + 64 * kvh; d.dst = gVts + (size_t)(b * 128 + 64 * kvh) * 4352 + n0; d.ldd = 4352; return d; }
        r -= ND_;
        { const int b = r >> 3, pb = (r >> 1) & 3, kvh = r & 1;
            d.src = p.in[3] + ((size_t)(b * 256 + 64 * pb) * 2 + kvh) * 64; d.lds_ = 128; d.f32 = 1; d.dst = gVts + (size_t)(b * 128 + 64 * kvh) * 4352 + 4096 + 64 * pb; d.ldd = 4352; return d; }
    };
    for (int it = gw; it < NTOT_; it += 2 * NGW) {
        const int it2 = it + NGW; const bool has2 = it2 < NTOT_;
        const TItem dA = item_of(it); const TItem dB = item_of(has2 ? it2 : it);
        u32x4 vA[8], vB[8];
        titem_load(dA, vA, lane);
        if (has2) titem_load(dB, vB, lane);
        titem_finish(dA, vA, scr, lane);
        if (has2) titem_finish(dB, vB, scr, lane);
    }
    for (int e8 = blockIdx.x * 512 + tid; e8 < 8 * 256 * 128 / 8; e8 += gridDim.x * 512) { const int e = e8 * 8, b = e >> 15, rem = e & 32767;
        *(u32x4*)(gKs + (size_t)(b * 4352 + 4096) * 128 + rem) = ld8_f32(p.in[2] + e); }
    const float* qn = p.in[21]; const float* kn = p.in[22];
    const int sub = lane & 7;
    float qnw[8], knw[8];
#pragma unroll
    for (int j = 0; j < 8; ++j) { qnw[j] = qn[8 * sub + j] * (0.125f * LOG2E); knw[j] = kn[8 * sub + j]; }
    u32x4 nq = (u32x4){0u, 0u, 0u, 0u}, nk = nq, nv = nq;
#define PREP_LOADRAW(t_) do { const bf16_t* pr_ = P + (size_t)(t_) * 2816; nq = *(const u32x4*)(pr_ + 2048 + 8 * lane); nk = *(const u32x4*)(pr_ + 2560 + 8 * (lane & 15)); nv = *(const u32x4*)(pr_ + 2688 + 8 * (lane & 15)); } while (0)
    if (gw < T) PREP_LOADRAW(gw);
    for (int t = gw; t < T; t += NGW) {
        bf16_t* pr = P + (size_t)t * 2816;
        const u32x4 rawq = nq, rawk = nk, rawv = nv;
        if (t + NGW < T) PREP_LOADRAW(t + NGW);
        const bool smp = t >= TC; const int n = (t - TC) & 4095, bb = (t - TC) >> 12;
        const int pos = (sub < 4) ? (n >> 6) : (n & 63);
        float cs[8], sn[8];
#pragma unroll
        for (int j = 0; j < 8; ++j) { const int i = 8 * (sub & 1) + j; cs[j] = rt[pos * 16 + i]; sn[j] = rt[1024 + pos * 16 + i]; }
        const bool isx2 = (sub >> 1) & 1;
        { const u32x4 raw = rawq;
          float v[8] = {bflo(raw.x), bfhi(raw.x), bflo(raw.y), bfhi(raw.y), bflo(raw.z), bfhi(raw.z), bflo(raw.w), bfhi(raw.w)};
          float ss = 0.f;
#pragma unroll
          for (int j = 0; j < 8; ++j) ss += v[j] * v[j];
          ss += __shfl_xor(ss, 1); ss += __shfl_xor(ss, 2); ss += __shfl_xor(ss, 4);
          const float rs = rsqrtf(ss * (1.f / 64.f) + 1e-6f);
#pragma unroll
          for (int j = 0; j < 8; ++j) v[j] = v[j] * rs * qnw[j];
          if (smp) {
#pragma unroll
              for (int j = 0; j < 8; ++j) { const float pv = __shfl_xor(v[j], 2); v[j] = isx2 ? (v[j] * cs[j] + pv * sn[j]) : (v[j] * cs[j] - pv * sn[j]); }
          }
          u32x4 o; o.x = pk2(v[0], v[1]); o.y = pk2(v[2], v[3]); o.z = pk2(v[4], v[5]); o.w = pk2(v[6], v[7]);
          *(u32x4*)(pr + 2048 + 8 * lane) = o; }
        { const u32x4 raw = rawk;
          float v[8] = {bflo(raw.x), bfhi(raw.x), bflo(raw.y), bfhi(raw.y), bflo(raw.z), bfhi(raw.z), bflo(raw.w), bfhi(raw.w)};
          float ss = 0.f;
#pragma unroll
          for (int j = 0; j < 8; ++j) ss += v[j] * v[j];
          ss += __shfl_xor(ss, 1); ss += __shfl_xor(ss, 2); ss += __shfl_xor(ss, 4);
          const float rs = rsqrtf(ss * (1.f / 64.f) + 1e-6f);
#pragma unroll
          for (int j = 0; j < 8; ++j) v[j] = v[j] * rs * knw[j];
          if (!smp) {
              if (lane < 16) {
                  float* ok = p.out + O_GK + (size_t)t * 128 + 8 * lane;
                  *(f32x4*)ok = (f32x4){v[0], v[1], v[2], v[3]}; *(f32x4*)(ok + 4) = (f32x4){v[4], v[5], v[6], v[7]};
                  u32x4 o; o.x = pk2(v[0], v[1]); o.y = pk2(v[2], v[3]); o.z = pk2(v[4], v[5]); o.w = pk2(v[6], v[7]);
                  *(u32x4*)(gKc + (size_t)t * 128 + 8 * lane) = o;
                  const u32x4 rv = rawv;
                  float* ov = p.out + O_GV + (size_t)t * 128 + 8 * lane;
                  *(f32x4*)ov = (f32x4){bflo(rv.x), bfhi(rv.x), bflo(rv.y), bfhi(rv.y)}; *(f32x4*)(ov + 4) = (f32x4){bflo(rv.z), bfhi(rv.z), bflo(rv.w), bfhi(rv.w)};
              }
          } else {
#pragma unroll
              for (int j = 0; j < 8; ++j) { const float pv = __shfl_xor(v[j], 2); v[j] = isx2 ? (v[j] * cs[j] + pv * sn[j]) : (v[j] * cs[j] - pv * sn[j]); }
              if (lane < 16) { u32x4 o; o.x = pk2(v[0], v[1]); o.y = pk2(v[2], v[3]); o.z = pk2(v[4], v[5]); o.w = pk2(v[6], v[7]);
                  *(u32x4*)(gKs + (size_t)(bb * 4352 + n) * 128 + 8 * lane) = o; }
          } }
    }
}

#undef PREP_LOADRAW
DI void phase_prep1(const Params& p, LAS unsigned char* lds) {
    const int tid = otid(), lane = tid & 63, wave = tid >> 6;
    const int gw = blockIdx.x * 8 + wave, NGW = gridDim.x * 8;
    const bf16_t* P = (const bf16_t*)(p.ws + WS_RB);
    unsigned char* RA = p.ws + WS_RA;
    bf16_t* nVt = (bf16_t*)(RA + RA_NVT); bf16_t* nKc = (bf16_t*)(RA + RA_NKC); bf16_t* nVtc = (bf16_t*)(RA + RA_NVTC);
    LAS unsigned short* scr = (LAS unsigned short*)(lds + wave * 8704);
    constexpr int NA_ = 640 * 16, NB_ = 8 * 4 * 16, NTOT_ = NA_ + NB_;
    auto item_of = [&](int it) {
        TItem d; d.f32 = 0; d.lds_ = 3072;
        int r = it;
        if (r < NA_) { const int tb = r >> 4, hd = r & 15, t0 = 64 * tb;
            d.src = P + (size_t)t0 * 3072 + 2048 + 64 * hd; d.dst = nVt + (size_t)(64 * hd) * T + t0; d.ldd = (size_t)T; return d; }
        r -= NA_;
        { const int b = r >> 6, pb = (r >> 4) & 3, hd = r & 15;
            d.src = p.in[7] + ((size_t)(b * 256 + 64 * pb) * 16 + hd) * 64; d.lds_ = 1024; d.f32 = 1; d.dst = nVtc + (size_t)(b * 1024 + 64 * hd) * 256 + 64 * pb; d.ldd = 256; return d; }
    };
    for (int it = gw; it < NTOT_; it += 2 * NGW) {
        const int it2 = it + NGW; const bool has2 = it2 < NTOT_;
        const TItem dA = item_of(it); const TItem dB = item_of(has2 ? it2 : it);
        u32x4 vA[8], vB[8];
        titem_load(dA, vA, lane);
        if (has2) titem_load(dB, vB, lane);
        titem_finish(dA, vA, scr, lane);
        if (has2) titem_finish(dB, vB, scr, lane);
    }
    for (int e8 = blockIdx.x * 512 + tid; e8 < 8 * 256 * 1024 / 8; e8 += gridDim.x * 512) *(u32x4*)(nKc + (size_t)e8 * 8) = ld8_f32(p.in[6] + (size_t)e8 * 8);
#pragma unroll 4
    for (int e = blockIdx.x * 512 + tid; e < TC * 256; e += gridDim.x * 512) { const int t = e >> 8, c8 = (e & 255) * 8;
        const u32x4 rv = *(const u32x4*)(P + (size_t)t * 3072 + 1024 + c8);
        float* o = (c8 < 1024) ? p.out + O_NK + (size_t)t * 1024 + c8 : p.out + O_NV + (size_t)t * 1024 + (c8 - 1024);
        *(f32x4*)o = (f32x4){bflo(rv.x), bfhi(rv.x), bflo(rv.y), bfhi(rv.y)}; *(f32x4*)(o + 4) = (f32x4){bflo(rv.z), bfhi(rv.z), bflo(rv.w), bfhi(rv.w)}; }
}

DI float log2_sigmoid(float x) { return -log1pf(expf(-x)) * LOG2E; }

DI void phase_r1(const Params& p) {
    const int tid = otid(), lane = tid & 63, wave = tid >> 6, r = lane & 31, hh = lane >> 5;
    const int gw = blockIdx.x * 8 + wave, NGW = gridDim.x * 8;
    unsigned char* RA = p.ws + WS_RA;
    const bf16_t* rKt = (const bf16_t*)(RA + RA_RKT); const bf16_t* rVt = (const bf16_t*)(RA + RA_RVT);
    float* KVs = (float*)(RA + RA_KVS);
    for (int it = gw; it < 160 * 8 * 2; it += NGW) {
        const int dir = it & 1, cidx = it >> 4, h = (it >> 1) & 7, t0 = 256 * cidx;
        const bool ctx = cidx < 32;
        const float l2 = log2_sigmoid(p.in[dir ? 19 : 18][h]);
        const float wa = dir ? 0.f : 255.f, ws = dir ? 1.f : -1.f;
        f32x16 acc[2][2];
#pragma unroll
        for (int a = 0; a < 2; ++a)
#pragma unroll
            for (int b = 0; b < 2; ++b)
#pragma unroll
                for (int i = 0; i < 16; ++i) acc[a][b][i] = 0.f;
        const bf16_t* vb = rVt + (size_t)(64 * h + r) * T + t0 + 8 * hh;
        const bf16_t* kb = rKt + (size_t)(64 * h + r) * T + t0 + 8 * hh;
#pragma unroll 2
        for (int ks = 0; ks < 16; ++ks) {
            const int j0 = 16 * ks + 8 * hh;
            bf16x8 aV[2], bK[2];
            float wj[8];
#pragma unroll
            for (int jj = 0; jj < 8; ++jj) wj[jj] = 0.125f * fexp2((wa + ws * (float)(j0 + jj)) * l2);
#pragma unroll
            for (int blk = 0; blk < 2; ++blk) {
                aV[blk] = *(const bf16x8*)(vb + (size_t)(32 * blk) * T + 16 * ks);
                const u32x4 kr = *(const u32x4*)(kb + (size_t)(32 * blk) * T + 16 * ks);
                u32x4 ow;
                ow.x = pk2(bflo(kr.x) * wj[0], bfhi(kr.x) * wj[1]); ow.y = pk2(bflo(kr.y) * wj[2], bfhi(kr.y) * wj[3]);
                ow.z = pk2(bflo(kr.z) * wj[4], bfhi(kr.z) * wj[5]); ow.w = pk2(bflo(kr.w) * wj[6], bfhi(kr.w) * wj[7]);
                bK[blk] = __builtin_bit_cast(bf16x8, ow);
            }
#pragma unroll
            for (int a = 0; a < 2; ++a)
#pragma unroll
                for (int b = 0; b < 2; ++b) {
                    const bf16x8 Af = ctx ? bK[a] : aV[a], Bf = ctx ? aV[b] : bK[b];
                    acc[a][b] = MFMA32(Af, Bf, acc[a][b]);
                }
        }
        float* od;
        if (ctx) od = p.out + (dir ? O_RB : O_RF) + (size_t)(cidx * 8 + h) * 4096;
        else { const int bc = cidx - 32, b = bc >> 4, c = bc & 15; od = KVs + ((size_t)((b * 8 + h) * 16 + c) * 2 + dir) * 4096; }
#pragma unroll
        for (int a = 0; a < 2; ++a)
#pragma unroll
            for (int b = 0; b < 2; ++b)
#pragma unroll
                for (int i = 0; i < 16; ++i) od[(32 * a + crow(i, hh)) * 64 + 32 * b + r] = acc[a][b][i];
    }
}
DI void phase_r2(const Params& p) {
    unsigned char* RA = p.ws + WS_RA;
    const float* KVs = (const float*)(RA + RA_KVS); bf16_t* FB = (bf16_t*)(RA + RA_FB);
    const int tid2 = otid();
    for (int e = blockIdx.x * 512 + tid2; e < 64 * 2 * 4096; e += gridDim.x * 512) {
        const int bh = e >> 13, dir = (e >> 12) & 1, el = e & 4095, dv = el >> 6, dk = el & 63, h = bh & 7;
        const float l2 = log2_sigmoid(p.in[dir ? 19 : 18][h]);
        const float gC = fexp2(256.f * l2);
        float S = p.in[dir ? 5 : 4][(size_t)bh * 4096 + dk * 64 + dv];
        if (dir == 0) { for (int c = 0; c < 16; ++c) { const size_t o = ((size_t)(bh * 16 + c) * 2) * 4096 + el; FB[o] = f2bf(S); S = gC * S + KVs[o]; } }
        else { for (int c = 15; c >= 0; --c) { const size_t o = ((size_t)(bh * 16 + c) * 2 + 1) * 4096 + el; FB[o] = f2bf(S); S = gC * S + KVs[o]; } }
    }
}

enum { MODE_SOFTMAX = 0, MODE_NA = 1, MODE_RET = 2 };
struct AttnUnit {
    const bf16_t* q; int ldq; bf16_t* o; int ldo;
    const bf16_t* k0; int ldk0; const bf16_t* vt0; int ldvt0; int nt0;
    const bf16_t* k1; int ldk1; const bf16_t* vt1; int ldvt1; int nt;
    float sc;
    int r_unit0, rlo;
    float l2f, l2b; const bf16_t* FB; const float* gn;
};
template <int MODE>
DI void attn_unit(LAS unsigned char* lds, const AttnUnit& U, LAS const float* rpbs) {
    const int tid = otid(), lane = tid & 63, w = __builtin_amdgcn_readfirstlane(tid >> 6), qi = lane & 31, hh = lane >> 5;
    const bf16_t* qrow = U.q + (size_t)(32 * w + qi) * U.ldq + 8 * hh;
    bf16x8 bq[4];
#pragma unroll
    for (int ks = 0; ks < 4; ++ks) bq[ks] = *(const bf16x8*)(qrow + 16 * ks);
    f32x16 o0, o1;
#pragma unroll
    for (int i = 0; i < 16; ++i) { o0[i] = 0.f; o1[i] = 0.f; }
    float m_run = -INFINITY, l_run = 0.f;
    const int sr = tid >> 3, scol = (tid & 7) * 8;
    const unsigned stoff = (unsigned)(sr * 72 + scol) * 2u;
    const unsigned vstoffA = (unsigned)(sr * 72 + 16 * ((tid & 7) >> 1) + 4 * (tid & 1)) * 2u;
    u32x4 kreg, vreg;
    const int nr = U.r_unit0 + (w >> 1), ncq = 32 * (w & 1) + qi;
    const int nr0 = min(max(nr - 4, 0), 56), nc0 = min(max(ncq - 8, 0), 48);
    const int iq = 32 * w + qi;
#define ATT_LOAD(t) do { const bf16_t *kp, *vp; if ((t) < U.nt0) { kp = U.k0 + (size_t)(64 * (t) + sr) * U.ldk0 + scol; vp = U.vt0 + (size_t)sr * U.ldvt0 + 64 * (t) + scol; } \
        else { const int t1 = (t) - U.nt0; kp = U.k1 + (size_t)(64 * t1 + sr) * U.ldk1 + scol; vp = U.vt1 + (size_t)sr * U.ldvt1 + 64 * t1 + scol; } \
        kreg = *(const u32x4*)kp; vreg = *(const u32x4*)vp; } while (0)
#define ATT_WRITE(b) do { *(LAS u32x4*)(lds + (b) * 18432 + stoff) = kreg; \
        *(LAS u32x2*)(lds + (b) * 18432 + 9216 + vstoffA) = (u32x2){vreg.x, vreg.y}; *(LAS u32x2*)(lds + (b) * 18432 + 9216 + vstoffA + 16) = (u32x2){vreg.z, vreg.w}; } while (0)
    __syncthreads();
    ATT_LOAD(0); ATT_WRITE(0);
    __syncthreads();
    for (int t = 0; t < U.nt; ++t) {
        const int cur = t & 1;
        if (t + 1 < U.nt) ATT_LOAD(t + 1);
        bool active = true; int dr = 0; bool win = false;
        if (MODE == MODE_NA) { win = t < U.nt0; if (win) { const int kr = U.rlo + t; active = (kr >= nr0) && (kr < nr0 + 8); dr = kr - nr + 7; } }
        if (active) {
            LAS const unsigned char* Kb = lds + cur * 18432; LAS const unsigned char* Vb = Kb + 9216;
            f32x16 s0, s1;
#pragma unroll
            for (int i = 0; i < 16; ++i) { s0[i] = 0.f; s1[i] = 0.f; }
#pragma unroll
            for (int ks = 0; ks < 4; ++ks) {
                const bf16x8 a0 = *(LAS const bf16x8*)(Kb + (qi * 72 + 16 * ks + 8 * hh) * 2);
                const bf16x8 a1 = *(LAS const bf16x8*)(Kb + ((32 + qi) * 72 + 16 * ks + 8 * hh) * 2);
                s0 = MFMA32(a0, bq[ks], s0); s1 = MFMA32(a1, bq[ks], s1);
            }
            if (MODE == MODE_RET) {
#pragma unroll
                for (int i = 0; i < 16; ++i) {
                    const int j0 = 64 * t + crow(i, hh), j1 = j0 + 32;
                    const int d0 = iq - j0, d1 = iq - j1;
                    const float w0 = 0.125f * fexp2(d0 >= 0 ? (float)d0 * U.l2f : (float)(-d0) * U.l2b);
                    const float w1 = 0.125f * fexp2(d1 >= 0 ? (float)d1 * U.l2f : (float)(-d1) * U.l2b);
                    s0[i] *= w0; s1[i] *= w1;
                }
            } else {
                if (MODE == MODE_NA && win) {
                    LAS const float* bp = rpbs + dr * 31 + 15 - ncq;
#pragma unroll
                    for (int i = 0; i < 16; ++i) {
                        const int kc0 = crow(i, hh), kc1 = kc0 + 32;
                        const bool v0 = (unsigned)(kc0 - nc0) < 16u, v1 = (unsigned)(kc1 - nc0) < 16u;
                        const float b0 = v0 ? bp[kc0] : 0.f, b1 = v1 ? bp[kc1] : 0.f;
                        s0[i] = v0 ? s0[i] + b0 : -INFINITY; s1[i] = v1 ? s1[i] + b1 : -INFINITY;
                    }
                }
                float mx = fmaxf(s0[0], s1[0]);
#pragma unroll
                for (int i = 1; i < 16; ++i) mx = fmaxf(fmaxf(mx, s0[i]), s1[i]);
                { const unsigned mu = __float_as_uint(mx); auto r2 = __builtin_amdgcn_permlane32_swap(mu, mu, false, false); mx = fmaxf(__uint_as_float(r2[0]), __uint_as_float(r2[1])); }
                const bool upd = mx > m_run + 8.f;
                if (__builtin_amdgcn_ballot_w64(upd) != 0ull) {
                    const float mn = upd ? mx : m_run;
                    const float alpha = fexp2(m_run - mn);
                    m_run = mn; l_run *= alpha;
#pragma unroll
                    for (int i = 0; i < 16; ++i) { o0[i] *= alpha; o1[i] *= alpha; }
                }
                const f32x2 mm = (f32x2){m_run, m_run};
                f32x2 ps2 = (f32x2){0.f, 0.f};
#pragma unroll
                for (int i = 0; i < 8; ++i) {
                    const f32x2 t0 = (f32x2){s0[2 * i], s0[2 * i + 1]} - mm, t1 = (f32x2){s1[2 * i], s1[2 * i + 1]} - mm;
                    s0[2 * i] = fexp2(t0.x); s0[2 * i + 1] = fexp2(t0.y); s1[2 * i] = fexp2(t1.x); s1[2 * i + 1] = fexp2(t1.y);
                    ps2 += (f32x2){s0[2 * i], s0[2 * i + 1]}; ps2 += (f32x2){s1[2 * i], s1[2 * i + 1]};
                }
                l_run += ps2.x + ps2.y;
            }
#pragma unroll
            for (int kb = 0; kb < 2; ++kb)
#pragma unroll
                for (int s = 0; s < 2; ++s) {
                    u32x4 pw;
                    if (kb == 0) { pw.x = pk2(s0[8 * s], s0[8 * s + 1]); pw.y = pk2(s0[8 * s + 2], s0[8 * s + 3]); pw.z = pk2(s0[8 * s + 4], s0[8 * s + 5]); pw.w = pk2(s0[8 * s + 6], s0[8 * s + 7]); }
                    else { pw.x = pk2(s1[8 * s], s1[8 * s + 1]); pw.y = pk2(s1[8 * s + 2], s1[8 * s + 3]); pw.z = pk2(s1[8 * s + 4], s1[8 * s + 5]); pw.w = pk2(s1[8 * s + 6], s1[8 * s + 7]); }
                    const bf16x8 pb = __builtin_bit_cast(bf16x8, pw);
                    const int koff = (32 * kb + 16 * s + 8 * hh) * 2;
                    const bf16x8 aV0 = *(LAS const bf16x8*)(Vb + (qi * 72) * 2 + koff);
                    const bf16x8 aV1 = *(LAS const bf16x8*)(Vb + ((32 + qi) * 72) * 2 + koff);
                    o0 = MFMA32(aV0, pb, o0); o1 = MFMA32(aV1, pb, o1);
                }
        }
        if (t + 1 < U.nt) ATT_WRITE(cur ^ 1);
        __syncthreads();
    }
#undef ATT_LOAD
#undef ATT_WRITE
    bf16_t* orow = U.o + (size_t)(32 * w + qi) * U.ldo;
    if (MODE == MODE_RET) {
        if (U.FB) {
            f32x16 c0, c1, e0, e1;
#pragma unroll
            for (int i = 0; i < 16; ++i) { c0[i] = 0.f; c1[i] = 0.f; e0[i] = 0.f; e1[i] = 0.f; }
            const bf16_t* Fp = U.FB + (size_t)qi * 64 + 8 * hh; const bf16_t* Bp = Fp + 4096;
#pragma unroll
            for (int ks = 0; ks < 4; ++ks) {
                const bf16x8 f0 = *(const bf16x8*)(Fp + 16 * ks), f1 = *(const bf16x8*)(Fp + 2048 + 16 * ks);
                const bf16x8 g0 = *(const bf16x8*)(Bp + 16 * ks), g1 = *(const bf16x8*)(Bp + 2048 + 16 * ks);
                c0 = MFMA32(f0, bq[ks], c0); c1 = MFMA32(f1, bq[ks], c1); e0 = MFMA32(g0, bq[ks], e0); e1 = MFMA32(g1, bq[ks], e1);
            }
            const float wf = fexp2((float)(iq + 1) * U.l2f), wb = fexp2((float)(256 - iq) * U.l2b);
#pragma unroll
            for (int i = 0; i < 16; ++i) { o0[i] += wf * c0[i] + wb * e0[i]; o1[i] += wf * c1[i] + wb * e1[i]; }
        }
        float s = 0.f;
#pragma unroll
        for (int i = 0; i < 16; ++i) s += o0[i] + o1[i];
        s += __shfl_xor(s, 32);
        const float mu = s * (1.f / 64.f);
        float vs = 0.f;
#pragma unroll
        for (int i = 0; i < 16; ++i) { const float a = o0[i] - mu, b = o1[i] - mu; vs += a * a + b * b; }
        vs += __shfl_xor(vs, 32);
        const float rstd = rsqrtf(vs * (1.f / 64.f) + 1e-5f);
#pragma unroll
        for (int db = 0; db < 2; ++db)
#pragma unroll
            for (int g = 0; g < 4; ++g) { const int d = 32 * db + 8 * g + 4 * hh;
                const u32x2 graw = *(const u32x2*)(orow + d);
                const f32x4 gw = *(const f32x4*)(U.gn + d);
                const float g0 = silu_f(bflo(graw.x)), g1 = silu_f(bfhi(graw.x)), g2 = silu_f(bflo(graw.y)), g3 = silu_f(bfhi(graw.y));
                const float x0 = (db ? o1[4 * g] : o0[4 * g]), x1 = (db ? o1[4 * g + 1] : o0[4 * g + 1]), x2 = (db ? o1[4 * g + 2] : o0[4 * g + 2]), x3 = (db ? o1[4 * g + 3] : o0[4 * g + 3]);
                u32x2 ov; ov.x = pk2((x0 - mu) * rstd * gw.x * g0, (x1 - mu) * rstd * gw.y * g1); ov.y = pk2((x2 - mu) * rstd * gw.z * g2, (x3 - mu) * rstd * gw.w * g3);
                *(u32x2*)(orow + d) = ov; }
    } else {
        float l; { const unsigned lu = __float_as_uint(l_run); auto r2 = __builtin_amdgcn_permlane32_swap(lu, lu, false, false); l = __uint_as_float(r2[0]) + __uint_as_float(r2[1]); }
        const float inv = 1.f / l;
#pragma unroll
        for (int db = 0; db < 2; ++db)
#pragma unroll
            for (int g = 0; g < 4; ++g) { const int d = 32 * db + 8 * g + 4 * hh;
                const float x0 = (db ? o1[4 * g] : o0[4 * g]), x1 = (db ? o1[4 * g + 1] : o0[4 * g + 1]), x2 = (db ? o1[4 * g + 2] : o0[4 * g + 2]), x3 = (db ? o1[4 * g + 3] : o0[4 * g + 3]);
                u32x2 ov; ov.x = pk2(x0 * inv, x1 * inv); ov.y = pk2(x2 * inv, x3 * inv);
                *(u32x2*)(orow + d) = ov; }
    }
}

DI void phase_att0(const Params& p, LAS unsigned char* lds, bool dummy = false) {
    bf16_t* P = (bf16_t*)(p.ws + WS_RB);
    unsigned char* RA = p.ws + WS_RA;
    const bf16_t* rVt = (const bf16_t*)(RA + RA_RVT);
    const bf16_t* gKc = (const bf16_t*)(RA + RA_GKC); const bf16_t* gKs = (const bf16_t*)(RA + RA_GKS);
    const bf16_t* gVtc = (const bf16_t*)(RA + RA_GVTC); const bf16_t* gVts = (const bf16_t*)(RA + RA_GVTS);
    const bf16_t* FB = (const bf16_t*)(RA + RA_FB);
    for (int u = blockIdx.x; u < 2560; u += gridDim.x) {
        AttnUnit U;
        U.k1 = nullptr; U.vt1 = nullptr; U.ldk1 = 0; U.ldvt1 = 0; U.r_unit0 = 0; U.rlo = 0; U.l2f = 0.f; U.l2b = 0.f; U.FB = nullptr; U.gn = nullptr;
        U.sc = 0.125f * LOG2E;
        if (u < 1024) {
            int b, kvh, rem2;
            if (gridDim.x == 256) { const int x = blockIdx.x & 7, slot = blockIdx.x >> 3, k = u >> 8, set = x + 8 * (k >> 1); b = set >> 1; kvh = set & 1; rem2 = (k & 1) * 32 + slot; }
            else { b = u >> 7; const int rem = u & 127; kvh = rem >> 6; rem2 = rem & 63; }
            const int qh = 4 * kvh + (rem2 >> 4), qb = rem2 & 15;
            U.q = P + (size_t)(TC + b * 4096 + qb * 256) * 2816 + 2048 + 64 * qh; U.ldq = 2816; U.o = (bf16_t*)U.q; U.ldo = 2816;
            U.k0 = gKs + (size_t)b * 4352 * 128 + 64 * kvh; U.ldk0 = 128; U.vt0 = gVts + (size_t)(b * 128 + 64 * kvh) * 4352; U.ldvt0 = 4352; U.nt0 = 68; U.nt = 68;
            if (dummy) { U.o = (bf16_t*)(p.ws + WS_END); U.ldo = 64; }
            attn_unit<MODE_SOFTMAX>(lds, U, nullptr);
        } else if (u < 1280) {
            const int v = u - 1024, b = v >> 3, qh = v & 7, kvh = qh >> 2;
            U.q = P + (size_t)(b * 256) * 2816 + 2048 + 64 * qh; U.ldq = 2816; U.o = (bf16_t*)U.q; U.ldo = 2816;
            U.k0 = gKc + (size_t)b * 256 * 128 + 64 * kvh; U.ldk0 = 128; U.vt0 = gVtc + (size_t)(b * 128 + 64 * kvh) * 256; U.ldvt0 = 256; U.nt0 = 4; U.nt = 4;
            if (dummy) { U.o = (bf16_t*)(p.ws + WS_END); U.ldo = 64; }
            attn_unit<MODE_SOFTMAX>(lds, U, nullptr);
        } else {
            const int v = u - 1280, cidx = v >> 3, h = v & 7, t0 = 256 * cidx;
            U.q = P + (size_t)t0 * 2816 + 64 * h; U.ldq = 2816; U.o = P + (size_t)t0 * 2816 + 1536 + 64 * h; U.ldo = 2816;
            U.k0 = P + (size_t)t0 * 2816 + 512 + 64 * h; U.ldk0 = 2816; U.vt0 = rVt + (size_t)(64 * h) * T + t0; U.ldvt0 = T; U.nt0 = 4; U.nt = 4;
            U.l2f = log2_sigmoid(p.in[18][h]); U.l2b = log2_sigmoid(p.in[19][h]); U.gn = p.in[20] + 64 * h;
            if (cidx >= 32) { const int bc = cidx - 32, b = bc >> 4, c = bc & 15; U.FB = FB + ((size_t)((b * 8 + h) * 16 + c) * 2) * 4096; }
            if (dummy) { U.o = (bf16_t*)(p.ws + WS_END); U.ldo = 64; }
            attn_unit<MODE_RET>(lds, U, nullptr);
        }
    }
}
DI void phase_att1(const Params& p, LAS unsigned char* lds, bool dummy = false) {
    bf16_t* P = (bf16_t*)(p.ws + WS_RB);
    unsigned char* RA = p.ws + WS_RA;
    const bf16_t* nVt = (const bf16_t*)(RA + RA_NVT); const bf16_t* nKc = (const bf16_t*)(RA + RA_NKC); const bf16_t* nVtc = (const bf16_t*)(RA + RA_NVTC);
    LAS float* rpbs = (LAS float*)(lds + 40960);
    for (int u = blockIdx.x; u < 2560; u += gridDim.x) {
        AttnUnit U;
        U.l2f = 0.f; U.l2b = 0.f; U.FB = nullptr; U.gn = nullptr; U.sc = 0.125f * LOG2E;
        if (u < 2048) {
            int b, hd, rg;
            if (gridDim.x == 256) { const int x = blockIdx.x & 7, slot = blockIdx.x >> 3, j = (u >> 8) * 32 + slot, pair = 16 * x + (j >> 4); b = pair >> 4; hd = pair & 15; rg = j & 15; }
            else { b = u >> 8; hd = (u >> 4) & 15; rg = u & 15; }
            const int rlo = min(max(4 * rg - 4, 0), 56), rhi0 = min(max(4 * rg - 1, 0), 56), nwin = rhi0 + 8 - rlo;
            const int tb = TC + b * 4096;
            __syncthreads();
            for (int e = otid(); e < 465; e += 512) rpbs[e] = p.in[25][(size_t)hd * 465 + e] * LOG2E;
            U.q = P + (size_t)(tb + 256 * rg) * 3072 + 64 * hd; U.ldq = 3072; U.o = (bf16_t*)U.q; U.ldo = 3072;
            U.k0 = P + (size_t)(tb + 64 * rlo) * 3072 + 1024 + 64 * hd; U.ldk0 = 3072; U.vt0 = nVt + (size_t)(64 * hd) * T + tb + 64 * rlo; U.ldvt0 = T; U.nt0 = nwin;
            U.k1 = nKc + (size_t)(b * 256) * 1024 + 64 * hd; U.ldk1 = 1024; U.vt1 = nVtc + (size_t)(b * 1024 + 64 * hd) * 256; U.ldvt1 = 256; U.nt = nwin + 4;
            U.r_unit0 = 4 * rg; U.rlo = rlo;
            if (dummy) { U.o = (bf16_t*)(p.ws + WS_END); U.ldo = 64; }
            attn_unit<MODE_NA>(lds, U, rpbs);
        } else {
            const int v = u - 2048, b = v >> 4, hd = v & 15;
            U.k1 = nullptr; U.vt1 = nullptr; U.ldk1 = 0; U.ldvt1 = 0; U.r_unit0 = 0; U.rlo = 0;
            U.q = P + (size_t)(b * 256) * 3072 + 64 * hd; U.ldq = 3072; U.o = (bf16_t*)U.q; U.ldo = 3072;
            U.k0 = P + (size_t)(b * 256) * 3072 + 1024 + 64 * hd; U.ldk0 = 3072; U.vt0 = nVt + (size_t)(64 * hd) * T + b * 256; U.ldvt0 = T; U.nt0 = 4; U.nt = 4;
            if (dummy) { U.o = (bf16_t*)(p.ws + WS_END); U.ldo = 64; }
            attn_unit<MODE_SOFTMAX>(lds, U, nullptr);
        }
    }
}

__global__ void __launch_bounds__(512, 2) fwd_megakernel(Params p) {
    extern __shared__ __attribute__((aligned(16))) unsigned char lds_raw[];
    LAS unsigned char* lds = (LAS unsigned char*)lds_raw;
    cg::grid_group grid = cg::this_grid();
    const int G = gridDim.x;
    float* X = p.out;
    float* mod = (float*)(p.ws + WS_MOD);
    bf16_t* H = (bf16_t*)(p.ws + WS_H); bf16_t* Y = (bf16_t*)(p.ws + WS_Y); bf16_t* PB = (bf16_t*)(p.ws + WS_RB); bf16_t* Y2 = (bf16_t*)(p.ws + WS_END);
    const float* npre = p.in[12]; const float* npost = p.in[13];
    unsigned* barw = (unsigned*)(p.ws + WS_CTL);
    if (blockIdx.x == 0) for (int e = threadIdx.x; e < XCD_BAR_WORDS; e += 512) barw[e] = 0u;
    if (threadIdx.x < 4) ((LAS unsigned*)(lds + 131072))[threadIdx.x] = 0u;
    __syncthreads();
    XcdBarrier xbar; xbar.bar = barw; xbar.x = 0; xbar.st = (volatile LAS unsigned*)(lds + 131072);
#define SYNC() xcd_barrier(xbar)
#define GEMM(Aptr, lda_, Bptr, N_, K_, EPI) do { g8::Gemm g{Aptr, lda_, Bptr, T, N_, K_}; g8::StaticOrder S; S.init(T, N_, K_, G, (int)blockIdx.x); g8::gemm_phase(lds, g, S, EPI); } while (0)
#define GEMM_Y(Aptr, lda_, Bptr, K_) do { g8::Gemm g{Aptr, lda_, Bptr, T, 1024, K_}; g8::SplitOrder S; S.init(K_, (int)blockIdx.x); g8::gemm_phase(lds, g, S, (g8::EpiBf16{Y, 1024, Y2})); } while (0)

    phase_mod(p.in[8], p.in[9], p.in[10], p.in[11], mod, (LAS float*)lds);
    phase_weights(p, lds);
    grid.sync();
    xbar = xcd_barrier_post(barw, (volatile LAS unsigned*)(lds + 131072));
    for (int l = 0; l < 2; ++l) {
        const float* modl = mod + (size_t)l * 9 * 9216;
        if (l == 0) row_phase<false, true, false, false>(p.in[0], p.in[1], X, nullptr, nullptr, H, nullptr, 0, 0.f, nullptr, modl, 0, npre + (l * 3 + 0) * 1024);
        else row_phase<true, true>(X, X + (size_t)TC * 1024, X, Y, Y2, H, mod, 8, 0.5f, npost + (0 * 3 + 2) * 1024, modl, 0, npre + (l * 3 + 0) * 1024);
        SYNC();
        GEMM(H, 1024, (const bf16_t*)(p.ws + WS_FIN + (size_t)(l * 2 + 0) * SZ_FIN), 5632, 1024, (g8::EpiSwiGLU{PB}));
        SYNC();
        GEMM_Y(PB, DFF, (const bf16_t*)(p.ws + WS_FOUT + (size_t)(l * 2 + 0) * SZ_FOUT), DFF);
        SYNC();
        if (PROBE & 4) { row_phase<true, true, true>(X, X + (size_t)TC * 1024, (float*)(p.ws + WS_END + 33554432), Y, Y2, (bf16_t*)(p.ws + WS_END + 33554432 + 262144), modl, 2, 0.5f, npost + (l * 3 + 0) * 1024, modl, 3, npre + (l * 3 + 1) * 1024); SYNC(); }
        row_phase<true, true>(l == 0 ? p.in[0] : X, l == 0 ? p.in[1] : X + (size_t)TC * 1024, X, Y, Y2, H, modl, 2, 0.5f, npost + (l * 3 + 0) * 1024, modl, 3, npre + (l * 3 + 1) * 1024);
        SYNC();
        if (l == 0) {
            GEMM(H, 1024, (const bf16_t*)(p.ws + WS_ABIN), 2816, 1024, (g8::EpiBf16{PB, 2816}));
            SYNC();
            phase_prep0(p, lds);
            SYNC();
            phase_r1(p);
            SYNC();
            phase_r2(p);
            SYNC();
            if (PROBE & 2) { phase_att0(p, lds, true); SYNC(); }
            phase_att0(p, lds);
            SYNC();
            GEMM_Y(PB + 1536, 2816, (const bf16_t*)(p.ws + WS_ABOUT), 1024);
        } else {
            GEMM(H, 1024, (const bf16_t*)(p.ws + WS_NAQKV), 3072, 1024, (g8::EpiBf16{PB, 3072}));
            SYNC();
            phase_prep1(p, lds);
            SYNC();
            if (PROBE & 2) { phase_att1(p, lds, true); SYNC(); }
            phase_att1(p, lds);
            SYNC();
            GEMM_Y(PB, 3072, (const bf16_t*)(p.ws + WS_NAOUT), 1024);
        }
        SYNC();
        if (PROBE & 4) { row_phase<true, true, true>(X, X + (size_t)TC * 1024, (float*)(p.ws + WS_END + 33554432), Y, Y2, (bf16_t*)(p.ws + WS_END + 33554432 + 262144), modl, 5, 1.0f, npost + (l * 3 + 1) * 1024, modl, 6, npre + (l * 3 + 2) * 1024); SYNC(); }
        row_phase<true, true>(X, X + (size_t)TC * 1024, X, Y, Y2, H, modl, 5, 1.0f, npost + (l * 3 + 1) * 1024, modl, 6, npre + (l * 3 + 2) * 1024);
        SYNC();
        GEMM(H, 1024, (const bf16_t*)(p.ws + WS_FIN + (size_t)(l * 2 + 1) * SZ_FIN), 5632, 1024, (g8::EpiSwiGLU{PB}));
        SYNC();
        GEMM_Y(PB, DFF, (const bf16_t*)(p.ws + WS_FOUT + (size_t)(l * 2 + 1) * SZ_FOUT), DFF);
        SYNC();
    }
    row_phase<true, false>(X, X + (size_t)TC * 1024, X, Y, Y2, nullptr, mod + (size_t)9 * 9216, 8, 0.5f, npost + (1 * 3 + 2) * 1024, nullptr, 0, nullptr);
}

extern "C" void kernel_launch(void* const* d_in, const int* in_sizes, int n_in, void* d_out, int out_size, void* d_ws, size_t ws_size, hipStream_t stream) {
    static int grid = 0;
    if (grid == 0) {
        int dev = 0, cus = 0, per_cu = 0;
        hipGetDevice(&dev);
        hipDeviceGetAttribute(&cus, hipDeviceAttributeMultiprocessorCount, dev);
        if (hipFuncSetAttribute((const void*)fwd_megakernel, hipFuncAttributeMaxDynamicSharedMemorySize, LDS_BYTES) != hipSuccess) fprintf(stderr, "kernel_launch: hipFuncSetAttribute failed\n");
        hipOccupancyMaxActiveBlocksPerMultiprocessor(&per_cu, (const void*)fwd_megakernel, 512, LDS_BYTES);
        (void)hipGetLastError();
        if (per_cu < 1) { fprintf(stderr, "kernel_launch: occupancy query says %d blocks/CU\n", per_cu); per_cu = 1; }
        grid = cus;
        if (ws_size < WS_END) fprintf(stderr, "kernel_launch: workspace too small: %zu < %zu\n", ws_size, (size_t)WS_END);
        if (n_in != 26) fprintf(stderr, "kernel_launch: expected 26 inputs, got %d\n", n_in);
    }
    Params p{};
    for (int i = 0; i < 26; ++i) p.in[i] = (const float*)d_in[i];
    p.out = (float*)d_out; p.ws = (unsigned char*)d_ws;
    void* args[] = {&p};
    hipError_t e = hipLaunchCooperativeKernel((const void*)fwd_megakernel, dim3(grid), dim3(512), args, LDS_BYTES, stream);
    if (e != hipSuccess) fprintf(stderr, "cooperative launch failed: %s (grid %d)\n", hipGetErrorString(e), grid);
}
```

```cpp
#include <hip/hip_runtime.h>
#include <hip/hip_cooperative_groups.h>
#include <cstdio>
#include <cstdint>
namespace cg = cooperative_groups;

#define LAS __attribute__((address_space(3)))
#define DI __device__ __forceinline__
typedef unsigned short bf16_t;
typedef short bf16x8 __attribute__((ext_vector_type(8)));
typedef float f32x4 __attribute__((ext_vector_type(4)));
typedef float f32x2 __attribute__((ext_vector_type(2)));
typedef float f32x16 __attribute__((ext_vector_type(16)));
typedef unsigned u32x4 __attribute__((ext_vector_type(4)));
typedef unsigned u32x2 __attribute__((ext_vector_type(2)));
typedef __bf16 bf16x2_t __attribute__((ext_vector_type(2)));

#ifndef PROBE
#define PROBE 0
#endif
constexpr int T = 40960, TC = 8192, D = 1024, DFF = 2816;
constexpr int LDS_BYTES = 131072 + 16;
constexpr float LOG2E = 1.4426950408889634f;
constexpr size_t O_GK = 41943040, O_GV = 42991616, O_RF = 44040192, O_RB = 45088768, O_NK = 46137344, O_NV = 54525952;
constexpr size_t WS_MOD = 0;
constexpr size_t WS_CTL = 786432;
constexpr size_t WS_W = 1048576;
constexpr size_t SZ_FIN = (size_t)5632 * 1024 * 2, SZ_FOUT = (size_t)1024 * 2816 * 2;
constexpr size_t WS_FIN = WS_W;
constexpr size_t WS_FOUT = WS_FIN + 4 * SZ_FIN;
constexpr size_t WS_ABIN = WS_FOUT + 4 * SZ_FOUT;
constexpr size_t WS_ABOUT = WS_ABIN + (size_t)2816 * 1024 * 2;
constexpr size_t WS_NAQKV = WS_ABOUT + (size_t)1024 * 1024 * 2;
constexpr size_t WS_NAOUT = WS_NAQKV + (size_t)3072 * 1024 * 2;
constexpr size_t WS_RA = WS_NAOUT + (size_t)1024 * 1024 * 2;
constexpr size_t SZ_H = (size_t)T * 1024 * 2;
constexpr size_t WS_H = WS_RA, WS_Y = WS_RA + SZ_H;
constexpr size_t WS_RB = WS_RA + 2 * SZ_H;
constexpr size_t WS_END = WS_RB + (size_t)T * 3072 * 2;
constexpr size_t RA_RKT = 0, RA_RVT = 41943040, RA_GKC = 83886080, RA_GKS = 85983232, RA_GVTC = 94896128, RA_GVTS = 96993280,
                 RA_KVS = 105906176, RA_FB = 139460608;
constexpr size_t RA_NVT = 0, RA_NKC = 83886080, RA_NVTC = 88080384;

DI unsigned pk2(float lo, float hi) { bf16x2_t v = __builtin_convertvector((f32x2){lo, hi}, bf16x2_t); return __builtin_bit_cast(unsigned, v); }
DI bf16_t f2bf(float f) { return (bf16_t)(pk2(f, 0.f) & 0xffffu); }
DI float bf2f(unsigned short b) { return __uint_as_float(((unsigned)b) << 16); }
DI float bflo(unsigned u) { return __uint_as_float(u << 16); }
DI float bfhi(unsigned u) { return __uint_as_float(u & 0xffff0000u); }
DI float wave_sum(float v) {
#pragma unroll
    for (int o = 32; o >= 1; o >>= 1) v += __shfl_xor(v, o);
    return v;
}
DI float fexp2(float x) { return __builtin_amdgcn_exp2f(x); }
DI float silu_f(float g) { return g * __builtin_amdgcn_rcpf(1.f + fexp2(-LOG2E * g)); }
#define LDS_WAIT() asm volatile("s_waitcnt lgkmcnt(0)" ::: "memory")
#define MFMA32(a, b, c) __builtin_amdgcn_mfma_f32_32x32x16_bf16((a), (b), (c), 0, 0, 0)
DI int otid() { int t = threadIdx.x; asm volatile("" : "+v"(t)); return t; }
DI int crow(int i, int h) { return (i & 3) + 8 * (i >> 2) + 4 * h; }


#define XB_TMO      128
#define XB_XCNT(j)  (256  + 64 * (j))
#define XB_XSUB(j)  (1280 + 64 * (j))
#define XB_XGEN(j)  (2304 + 64 * (j))
#define XB_TOP      3328
#define XB_TOPGEN   3392
#define XCD_BAR_WORDS 3456
#define XB_SPIN_CAP (1u << 22)
DI unsigned xb_ld(unsigned* p)              { return __hip_atomic_load(p, __ATOMIC_RELAXED, __HIP_MEMORY_SCOPE_AGENT); }
DI unsigned xb_add(unsigned* p, unsigned v) { return __hip_atomic_fetch_add(p, v, __ATOMIC_RELAXED, __HIP_MEMORY_SCOPE_AGENT); }
DI unsigned xb_xcc_id() { return (unsigned)__builtin_amdgcn_s_getreg((3 << 11) | 20) & 0xFu; }
#define XB_SPIN(cond, bar) do { unsigned _sp = 0; while (cond) { __builtin_amdgcn_s_sleep(1); \
    if ((++_sp & 255u) == 0u) { if (xb_ld(&(bar)[XB_TMO])) break; if (_sp > XB_SPIN_CAP) { atomicAdd(&(bar)[XB_TMO], 1u); break; } } } } while (0)
struct XcdBarrier { unsigned* bar; unsigned x; volatile LAS unsigned* st; };
DI XcdBarrier xcd_barrier_post(unsigned* bar, volatile LAS unsigned* st) {
    XcdBarrier b; b.bar = bar; b.x = xb_xcc_id(); b.st = st;
    if (threadIdx.x == 0) (void)xb_add(&bar[XB_XCNT(b.x)], 1u);
    return b;
}
DI void xcd_barrier_complete(unsigned* bar, unsigned x, unsigned& nloc, unsigned& nx) {
    const unsigned G = gridDim.x * gridDim.y * gridDim.z;
    unsigned sum, cnt, mine, sp = 0u;
    for (;;) {
        sum = 0u; cnt = 0u; mine = 0u;
#pragma unroll
        for (unsigned j = 0; j < 16; ++j) { const unsigned c = xb_ld(&bar[XB_XCNT(j)]); sum += c; cnt += (c > 0u) ? 1u : 0u; mine = (j == x) ? c : mine; }
        if (sum == G) break;
        __builtin_amdgcn_s_sleep(1);
        if ((++sp & 255u) == 0u) { if (xb_ld(&bar[XB_TMO])) break; if (sp > XB_SPIN_CAP) { atomicAdd(&bar[XB_TMO], 1u); break; } }
    }
    nloc = mine > 0u ? mine : 1u; nx = cnt > 0u ? cnt : 1u;
}
DI void xcd_barrier(const XcdBarrier& b) {
    asm volatile("s_waitcnt vmcnt(0)" ::: "memory");
    __syncthreads();
    if (threadIdx.x == 0) {
        unsigned* bar = b.bar;
        __builtin_amdgcn_s_waitcnt(0);
        unsigned nloc = b.st[0], nx = b.st[1];
        if (nloc == 0u) { xcd_barrier_complete(bar, b.x, nloc, nx); b.st[0] = nloc; b.st[1] = nx; }
        const unsigned old = xb_add(&bar[XB_XSUB(b.x)], 1u);
        const unsigned gen = old / nloc;
        if (old + 1u == (gen + 1u) * nloc) {
            __builtin_amdgcn_fence(__ATOMIC_RELEASE, "agent");
            asm volatile("s_waitcnt vmcnt(0)" ::: "memory");
            const unsigned og = xb_add(&bar[XB_TOP], 1u);
            const unsigned tg = og / nx;
            if (og + 1u == (tg + 1u) * nx) xb_add(&bar[XB_TOPGEN], 1u);
            else XB_SPIN(xb_ld(&bar[XB_TOPGEN]) == tg, bar);
            __builtin_amdgcn_fence(__ATOMIC_ACQUIRE, "agent");
            xb_add(&bar[XB_XGEN(b.x)], 1u);
            asm volatile("s_waitcnt vmcnt(0)" ::: "memory");
        } else {
            XB_SPIN(xb_ld(&bar[XB_XGEN(b.x)]) == gen, bar);
            __builtin_amdgcn_fence(__ATOMIC_ACQUIRE, "agent");
            asm volatile("s_waitcnt vmcnt(0)" ::: "memory");
        }
    }
    __syncthreads();
}

namespace g8 {
constexpr int BM = 256, BK = 64, HALF = 128, HTB = HALF * BK * 2, NXCD = 8, WGM = 4;
DI int lds_byte(int r, int c) { const int st = (r >> 4) * 2 + (c >> 5), rr = r & 15, cc = c & 31, ob = rr * 64 + cc * 2; return st * 1024 + (ob ^ (((ob >> 9) & 1) << 5)); }
DI void stage_rc(int b, int& R, int& C) { const int st = b / 1024, sb = b % 1024, swz = sb ^ (((sb >> 9) & 1) << 5); R = (st >> 1) * 16 + swz / 64; C = (st & 1) * 32 + (swz % 64) / 2; }
DI int perm32(int rho) { const int n = rho >> 4, i = rho & 15; return 8 * (i >> 2) + 4 * n + (i & 3); }
struct Unit { int pm, pn, kt0, nt, part; };
struct Gemm { const bf16_t* A; int lda; const bf16_t* Bt; int M, N, K; };
struct StaticOrder {
    int nM, nN, nwg, G, c, ntk;
    DI void init(int M, int N, int K, int G_, int c_) { nM = M / BM; nN = N / BM; nwg = nM * nN; G = G_; c = c_; ntk = K / BK; }
    DI bool next(int i, Unit& u) const {
        const long L = (long)i * G + c; if (L >= nwg) return false;
        int wgid = (int)L; { const int q = nwg / NXCD, r = nwg % NXCD, xcd = wgid % NXCD, off = wgid / NXCD; wgid = (xcd < r ? xcd * (q + 1) : r * (q + 1) + (xcd - r) * q) + off; }
        const int nig = WGM * nN, gid = wgid / nig, fm = gid * WGM, gsz = (nM - fm) < WGM ? (nM - fm) : WGM;
        u.pm = fm + ((wgid % nig) % gsz); u.pn = (wgid % nig) / gsz; u.kt0 = 0; u.nt = ntk; u.part = 0; return true;
    }
};
struct SplitOrder {
    int ntk, c;
    DI void init(int K, int c_) { ntk = K / BK; c = c_; }
    DI bool next(int i, Unit& u) const {
        const int xcd = c & 7, slot = c >> 3;
        if (i < 2) { const int L = i * 256 + xcd * 32 + slot; u.pm = L >> 2; u.pn = L & 3; u.kt0 = 0; u.nt = ntk; u.part = 0; return true; }
        if (i == 2) { const int L = 512 + xcd * 16 + (slot >> 1), hf = slot & 1; u.pm = L >> 2; u.pn = L & 3; u.kt0 = hf * (ntk >> 1); u.nt = ntk >> 1; u.part = hf; return true; }
        return false;
    }
};
struct EpiBf16 {
    bf16_t* O; int ldc; bf16_t* O2 = nullptr;
    DI void operator()(const f32x4 (&acc)[2][2][4][2], const Unit& u, int wr, int wc, int fr, int fq) const {
        const int row0 = u.pm * BM + wr * 64 + fr, col0 = u.pn * BM + wc * 32 + 8 * fq;
#pragma unroll
        for (int ai = 0; ai < 2; ++ai)
#pragma unroll
            for (int m = 0; m < 4; ++m) { bf16_t* rowp = (u.part ? O2 - (size_t)32768 * ldc : O) + (size_t)(row0 + ai * HALF + m * 16) * ldc + col0;
#pragma unroll
                for (int bj = 0; bj < 2; ++bj) { const f32x4 v0 = acc[ai][bj][m][0], v1 = acc[ai][bj][m][1];
                    u32x4 w; w.x = pk2(v0[0], v0[1]); w.y = pk2(v0[2], v0[3]); w.z = pk2(v1[0], v1[1]); w.w = pk2(v1[2], v1[3]);
                    *(u32x4*)(rowp + bj * HALF) = w; } }
    }
};
struct EpiSwiGLU {
    bf16_t* O;
    DI void operator()(const f32x4 (&acc)[2][2][4][2], const Unit& u, int wr, int wc, int fr, int fq) const {
        const int row0 = u.pm * BM + wr * 64 + fr, col0 = u.pn * HALF + wc * 32 + 8 * fq;
#pragma unroll
        for (int ai = 0; ai < 2; ++ai)
#pragma unroll
            for (int m = 0; m < 4; ++m) { bf16_t* rowp = O + (size_t)(row0 + ai * HALF + m * 16) * DFF + col0;
                float r[8];
#pragma unroll
                for (int n = 0; n < 2; ++n)
#pragma unroll
                    for (int j = 0; j < 4; ++j) { const float g = acc[ai][0][m][n][j], up = acc[ai][1][m][n][j]; r[4 * n + j] = silu_f(g) * up; }
                u32x4 w; w.x = pk2(r[0], r[1]); w.y = pk2(r[2], r[3]); w.z = pk2(r[4], r[5]); w.w = pk2(r[6], r[7]);
                *(u32x4*)rowp = w; }
    }
};

template <class Epi, class Order>
DI void gemm_phase(LAS unsigned char* lds, const Gemm g, const Order& S, const Epi& E) {
    const int tid = otid(), wid = __builtin_amdgcn_readfirstlane(tid >> 6), lane = tid & 63, wr = wid >> 2, wc = wid & 3, fr = lane & 15, fq = lane >> 4;
    const int K = g.K, lda = g.lda;
    unsigned voffA[2], voffB[2];
#pragma unroll
    for (int i = 0; i < 2; ++i) { int R, C; stage_rc(tid * 16 + i * 8192, R, C); const int Rb = (R & ~31) + perm32(R & 31);
        voffA[i] = (unsigned)(R * lda + C) * 2u; voffB[i] = (unsigned)(Rb * K + C) * 2u; }
    const size_t kstep = (size_t)(BK * 2);
    const size_t hstepA = (size_t)HALF * lda * 2, hstepB = (size_t)HALF * K * 2;
    const size_t tstepA = 2 * hstepA, tstepB = 2 * hstepB;
    const unsigned ldsw = (unsigned)wid * 1024u;
    const int aoff = lds_byte(wr * 64 + fr, fq * 8), boff = lds_byte(wc * 32 + fr, fq * 8);
#define G8_SA(b, h) (((b) * 2 + (h)) * HTB)
#define G8_SB(b, h) ((4 + (b) * 2 + (h)) * HTB)
#define G8_STAGE(bufoff, gbase, voff) do { _Pragma("unroll") for (int _i = 0; _i < 2; ++_i) \
        __builtin_amdgcn_global_load_lds((const unsigned*)((const char*)(gbase) + (voff)[_i]), (LAS unsigned*)(lds + (bufoff) + ldsw + _i * 8192), 16, 0, 0); } while (0)
#define G8_LDA(dst, b, h) do { _Pragma("unroll") for (int m = 0; m < 4; ++m) _Pragma("unroll") for (int k = 0; k < 2; ++k) dst[m][k] = *(const LAS bf16x8*)(lds + G8_SA(b, h) + aoff + m * 2048 + k * 1024); } while (0)
#define G8_LDB(dst, b, h) do { _Pragma("unroll") for (int n = 0; n < 2; ++n) _Pragma("unroll") for (int k = 0; k < 2; ++k) dst[n][k] = *(const LAS bf16x8*)(lds + G8_SB(b, h) + boff + n * 2048 + k * 1024); } while (0)
#define G8_MMA(ai, bj, At, Bt) do { __builtin_amdgcn_s_setprio(1); _Pragma("unroll") for (int m = 0; m < 4; ++m) _Pragma("unroll") for (int n = 0; n < 2; ++n) _Pragma("unroll") for (int k = 0; k < 2; ++k) \
        acc[ai][bj][m][n] = __builtin_amdgcn_mfma_f32_16x16x32_bf16(Bt[n][k], At[m][k], acc[ai][bj][m][n], 0, 0, 0); __builtin_amdgcn_s_setprio(0); } while (0)
#define G8_WAIT_V(n) asm volatile("s_waitcnt vmcnt(" #n ")" ::: "memory")
#define G8_WAIT_L(n) asm volatile("s_waitcnt lgkmcnt(" #n ")" ::: "memory")
#define G8_BAR __builtin_amdgcn_s_barrier()
#define G8_SCHED __builtin_amdgcn_sched_barrier(0)
    Unit cur, nxt; int ui = 0;
    if (!S.next(0, cur)) return;
    f32x4 acc[2][2][4][2];
#pragma unroll
    for (int a = 0; a < 2; ++a)
#pragma unroll
        for (int b = 0; b < 2; ++b)
#pragma unroll
            for (int m = 0; m < 4; ++m)
#pragma unroll
                for (int n = 0; n < 2; ++n) acc[a][b][m][n] = (f32x4){0.f, 0.f, 0.f, 0.f};
    bf16x8 At[4][2], B0[2][2], B1[2][2];
    const char* cA = (const char*)g.A + (size_t)cur.pm * tstepA + (size_t)cur.kt0 * kstep; const char* cB = (const char*)g.Bt + (size_t)cur.pn * tstepB + (size_t)cur.kt0 * kstep;
    G8_STAGE(G8_SB(0, 0), cB, voffB); G8_STAGE(G8_SB(0, 1), cB + hstepB, voffB); G8_STAGE(G8_SA(0, 0), cA, voffA); G8_STAGE(G8_SA(0, 1), cA + hstepA, voffA);
    if (wr == 1) G8_BAR;
    G8_WAIT_V(2); G8_BAR;
    G8_STAGE(G8_SB(1, 0), cB + kstep, voffB); G8_STAGE(G8_SA(1, 0), cA + kstep, voffA); G8_STAGE(G8_SB(1, 1), cB + hstepB + kstep, voffB);
    G8_WAIT_V(6); G8_BAR;
    for (;;) {
        const bool has_next = S.next(ui + 1, nxt);
        const char* nA = has_next ? (const char*)g.A + (size_t)nxt.pm * tstepA + (size_t)nxt.kt0 * kstep : cA; const char* nB = has_next ? (const char*)g.Bt + (size_t)nxt.pn * tstepB + (size_t)nxt.kt0 * kstep : cB;
        const int nt = cur.nt;
        for (int t = 0; t < nt; t += 2) {
            const bool last = (t == nt - 2);
            const char* a1 = cA + (size_t)(t + 1) * kstep;
            const char* a2 = last ? nA : cA + (size_t)(t + 2) * kstep; const char* b2 = last ? nB : cB + (size_t)(t + 2) * kstep;
            const char* a3 = a2 + kstep; const char* b3 = b2 + kstep;
            G8_LDB(B0, 0, 0); G8_LDB(B1, 0, 1); G8_SCHED; G8_LDA(At, 0, 0); G8_STAGE(G8_SA(1, 1), a1 + hstepA, voffA);
            G8_WAIT_V(8); G8_WAIT_L(0); G8_BAR; G8_MMA(0, 0, At, B0); G8_MMA(0, 1, At, B1); G8_BAR; G8_SCHED;
            G8_LDA(At, 0, 1); G8_STAGE(G8_SB(0, 0), b2, voffB); G8_STAGE(G8_SB(0, 1), b2 + hstepB, voffB); G8_STAGE(G8_SA(0, 0), a2, voffA);
            G8_WAIT_V(8); G8_WAIT_L(0); G8_BAR; G8_MMA(1, 0, At, B0); G8_MMA(1, 1, At, B1); G8_BAR; G8_SCHED;
            G8_LDB(B0, 1, 0); G8_LDB(B1, 1, 1); G8_SCHED; G8_LDA(At, 1, 0); G8_STAGE(G8_SA(0, 1), a2 + hstepA, voffA);
            G8_WAIT_V(8); G8_WAIT_L(0); G8_BAR; G8_MMA(0, 0, At, B0); G8_MMA(0, 1, At, B1); G8_BAR; G8_SCHED;
            G8_LDA(At, 1, 1); G8_STAGE(G8_SB(1, 0), b3, voffB); G8_STAGE(G8_SB(1, 1), b3 + hstepB, voffB); G8_STAGE(G8_SA(1, 0), a3, voffA);
            G8_WAIT_V(8); G8_WAIT_L(0); G8_BAR; G8_MMA(1, 0, At, B0); G8_MMA(1, 1, At, B1); G8_BAR; G8_SCHED;
        }
        if (wr == 0) G8_BAR;
        E(acc, cur, wr, wc, fr, fq);
        if (!has_next) break;
#pragma unroll
        for (int a = 0; a < 2; ++a)
#pragma unroll
            for (int b = 0; b < 2; ++b)
#pragma unroll
                for (int m = 0; m < 4; ++m)
#pragma unroll
                    for (int n = 0; n < 2; ++n) acc[a][b][m][n] = (f32x4){0.f, 0.f, 0.f, 0.f};
        cur = nxt; cA = nA; cB = nB; ++ui;
        if (wr == 1) G8_BAR;
    }
    G8_WAIT_V(0);
    G8_BAR;
}
}

DI void phase_mod(const float* c, const float* c_ctx, const float* mod_w, const float* mod_b, float* mod, LAS float* lds) {
    const int tid = otid(), lane = tid & 63, wave = tid >> 6;
    LAS float* sc = lds;
    LAS float* red = lds + 9 * 1024;
    for (int idx = tid; idx < 9 * 1024; idx += 512) { const int ci = idx >> 10, k = idx & 1023; const float v = (ci == 0) ? c_ctx[k] : c[(ci - 1) * 1024 + k]; sc[idx] = silu_f(v); }
    __syncthreads();
    for (int item = blockIdx.x; item < 2 * 144; item += gridDim.x) {
        const int l = item / 144, j = (item % 144) * 64 + lane;
        float a0 = 0, a1 = 0, a2 = 0, a3 = 0, a4 = 0, a5 = 0, a6 = 0, a7 = 0, a8 = 0;
        const float* wp = mod_w + ((size_t)l * 1024 + wave * 128) * 9216 + j;
        LAS const float* sp = sc + wave * 128;
#pragma unroll 32
        for (int k = 0; k < 128; ++k) { const float w = wp[(size_t)k * 9216];
            a0 += sp[k] * w; a1 += sp[1024 + k] * w; a2 += sp[2048 + k] * w; a3 += sp[3072 + k] * w; a4 += sp[4096 + k] * w;
            a5 += sp[5120 + k] * w; a6 += sp[6144 + k] * w; a7 += sp[7168 + k] * w; a8 += sp[8192 + k] * w; }
        LAS float* rp = red + wave * 576 + lane;
        rp[0] = a0; rp[64] = a1; rp[128] = a2; rp[192] = a3; rp[256] = a4; rp[320] = a5; rp[384] = a6; rp[448] = a7; rp[512] = a8;
        __syncthreads();
        for (int e = tid; e < 576; e += 512) { float s = 0.f;
#pragma unroll
            for (int w2 = 0; w2 < 8; ++w2) s += red[w2 * 576 + e];
            const int ci = e >> 6, jj = (item % 144) * 64 + (e & 63);
            mod[((size_t)l * 9 + ci) * 9216 + jj] = s + mod_b[(size_t)l * 9216 + jj]; }
        __syncthreads();
    }
}
struct WItem { const float* W; bf16_t* WT; int K, N, mode, item; float qs; };
DI void witem_load(const WItem& d, f32x4 (&v)[8], int lane) {
    const int nblk = d.N / 32, kb = d.item / nblk, nb = d.item % nblk, k0 = 64 * kb, n0 = 32 * nb;
    const int lr = lane >> 3, c4 = (lane & 7) * 4;
#pragma unroll
    for (int i = 0; i < 8; ++i) v[i] = __builtin_nontemporal_load((const f32x4*)(d.W + (size_t)(k0 + 8 * i + lr) * d.N + n0 + c4));
}
DI void witem_finish(const WItem& d, const f32x4 (&v)[8], LAS float* scr, int lane) {
    const int nblk = d.N / 32, kb = d.item / nblk, nb = d.item % nblk, k0 = 64 * kb, n0 = 32 * nb;
    const int lr = lane >> 3, c4 = (lane & 7) * 4;
    const float cs = (n0 < 1024) ? d.qs : 1.f;
#pragma unroll
    for (int i = 0; i < 8; ++i) { LAS float* s = scr + (8 * i + lr) * 33 + c4; s[0] = v[i].x * cs; s[1] = v[i].y * cs; s[2] = v[i].z * cs; s[3] = v[i].w * cs; }
    LDS_WAIT();
    int d0 = n0;
    if (d.mode == 1) { const int bj = n0 / DFF, rem = n0 % DFF; d0 = 256 * (rem / 128) + 128 * bj + (rem % 128); }
    const int c = lane & 7;
#pragma unroll
    for (int j = 0; j < 4; ++j) { const int n = (lane >> 3) + 8 * j; LAS const float* s = scr + (8 * c) * 33 + n;
        u32x4 o; o.x = pk2(s[0 * 33], s[1 * 33]); o.y = pk2(s[2 * 33], s[3 * 33]); o.z = pk2(s[4 * 33], s[5 * 33]); o.w = pk2(s[6 * 33], s[7 * 33]);
        *(u32x4*)(d.WT + (size_t)(d0 + n) * d.K + k0 + 8 * c) = o; }
    LDS_WAIT();
}
struct Params { const float* in[26]; float* out; unsigned char* ws; };

DI WItem witem_of(const Params& p, int it) {
    constexpr int I_FIN = 16 * 176, I_FOUT = 44 * 32, I_ABIN = 16 * 88, I_ABOUT = 16 * 32, I_NAQKV = 16 * 96;
    WItem d; d.qs = 1.f; d.mode = 0;
    int r = it;
    if (r < 4 * I_FIN) { const int mi = r / I_FIN; d.W = p.in[14] + (size_t)mi * 1024 * 5632; d.K = 1024; d.N = 5632; d.WT = (bf16_t*)(p.ws + WS_FIN + mi * SZ_FIN); d.mode = 1; d.item = r % I_FIN; return d; } r -= 4 * I_FIN;
    if (r < 4 * I_FOUT) { const int mi = r / I_FOUT; d.W = p.in[15] + (size_t)mi * 2816 * 1024; d.K = 2816; d.N = 1024; d.WT = (bf16_t*)(p.ws + WS_FOUT + mi * SZ_FOUT); d.item = r % I_FOUT; return d; } r -= 4 * I_FOUT;
    if (r < I_ABIN) { d.W = p.in[16]; d.K = 1024; d.N = 2816; d.WT = (bf16_t*)(p.ws + WS_ABIN); d.item = r; return d; } r -= I_ABIN;
    if (r < I_ABOUT) { d.W = p.in[17]; d.K = 1024; d.N = 1024; d.WT = (bf16_t*)(p.ws + WS_ABOUT); d.item = r; return d; } r -= I_ABOUT;
    if (r < I_NAQKV) { d.W = p.in[23]; d.K = 1024; d.N = 3072; d.WT = (bf16_t*)(p.ws + WS_NAQKV); d.item = r; d.qs = 0.125f * LOG2E; return d; } r -= I_NAQKV;
    d.W = p.in[24]; d.K = 1024; d.N = 1024; d.WT = (bf16_t*)(p.ws + WS_NAOUT); d.item = r; return d;
}
DI void phase_weights(const Params& p, LAS unsigned char* lds) {
    const int tid = otid(), lane = tid & 63, wave = tid >> 6;
    LAS float* scr = (LAS float*)(lds + 57344 + wave * 8704);
    const int gw = blockIdx.x * 8 + wave, NGW = gridDim.x * 8;
    constexpr int NITEMS = 4 * (16 * 176) + 4 * (44 * 32) + 16 * 88 + 16 * 32 + 16 * 96 + 16 * 32;
    for (int it = gw; it < NITEMS; it += 2 * NGW) {
        const int it2 = it + NGW; const bool has2 = it2 < NITEMS;
        const WItem dA = witem_of(p, it); const WItem dB = witem_of(p, has2 ? it2 : it);
        f32x4 vA[8], vB[8];
        witem_load(dA, vA, lane);
        if (has2) witem_load(dB, vB, lane);
        witem_finish(dA, vA, scr, lane);
        if (has2) witem_finish(dB, vB, scr, lane);
    }
}

template <bool HAS_Y, bool HAS_H, int XS, int XD>
DI void row_phase(const float* x0, const float* x1, float* X, const bf16_t* Y, const bf16_t* Y2, bf16_t* H,
                  const float* modg, int sg, float wgt, const float* gpost, const float* modn, int sn, const float* gpre) {
    const int tid = otid(), lane = tid & 63, gw = blockIdx.x * 8 + (tid >> 6), NGW = gridDim.x * 8;
    for (int tA = gw; tA < T; tA += 2 * NGW) {
        const int tB = tA + NGW; const bool hasB = tB < T;
        f32x4 vA[4], vB[4]; u32x2 yA[4], yB[4], zA[4], zB[4];
#define ROW_LOAD(t, v, yr, zr) do { \
        if (XS == 0) { const float* xr = ((t) < TC) ? x0 + (size_t)(t) * 1024 : x1 + (size_t)((t) - TC) * 1024; \
            _Pragma("unroll") for (int j = 0; j < 4; ++j) v[j] = *(const f32x4*)(xr + 4 * lane + 256 * j); } \
        else { const bf16_t* xb = (const bf16_t*)X + (size_t)(t) * 2048 + 1024; \
            _Pragma("unroll") for (int j = 0; j < 4; ++j) { const u32x2 xr2 = *(const u32x2*)(xb + 4 * lane + 256 * j); v[j] = (f32x4){bflo(xr2.x), bfhi(xr2.x), bflo(xr2.y), bfhi(xr2.y)}; } } \
        if (HAS_Y) { _Pragma("unroll") for (int j = 0; j < 4; ++j) { yr[j] = *(const u32x2*)(Y + (size_t)(t) * 1024 + 4 * lane + 256 * j); \
            zr[j] = ((t) >= 32768) ? *(const u32x2*)(Y2 + (size_t)((t) - 32768) * 1024 + 4 * lane + 256 * j) : (u32x2){0u, 0u}; } } } while (0)
        ROW_LOAD(tA, vA, yA, zA);
        if (hasB) ROW_LOAD(tB, vB, yB, zB);
#undef ROW_LOAD
#define ROW_COMPUTE(t, v, yr, zr) do { \
        const int ci = (t) < TC ? 0 : 1 + (((t) - TC) >> 12); \
        if (HAS_Y) { f32x4 y[4]; float ss = 0.f; \
            _Pragma("unroll") for (int j = 0; j < 4; ++j) { \
                y[j] = (f32x4){bflo(yr[j].x) + bflo(zr[j].x), bfhi(yr[j].x) + bfhi(zr[j].x), bflo(yr[j].y) + bflo(zr[j].y), bfhi(yr[j].y) + bfhi(zr[j].y)}; \
                ss += (y[j].x * y[j].x + y[j].y * y[j].y) + (y[j].z * y[j].z + y[j].w * y[j].w); } \
            ss = wave_sum(ss); \
            const float r = rsqrtf(ss * (1.f / 1024.f) + 1e-6f) * wgt; \
            const float* gate = modg + (size_t)ci * 9216 + sg * 1024; \
            _Pragma("unroll") for (int j = 0; j < 4; ++j) { const f32x4 g = *(const f32x4*)(gate + 4 * lane + 256 * j); const f32x4 gp = *(const f32x4*)(gpost + 4 * lane + 256 * j); \
                v[j] = v[j] + (g * gp) * (y[j] * r); } } \
        if (XD == 2) { float* xo = X + (size_t)(t) * 1024; \
            _Pragma("unroll") for (int j = 0; j < 4; ++j) *(f32x4*)(xo + 4 * lane + 256 * j) = v[j]; } \
        if (XD == 1) { bf16_t* xo = (bf16_t*)X + (size_t)(t) * 2048 + 1024; \
            _Pragma("unroll") for (int j = 0; j < 4; ++j) { u32x2 o; o.x = pk2(v[j].x, v[j].y); o.y = pk2(v[j].z, v[j].w); *(u32x2*)(xo + 4 * lane + 256 * j) = o; \
                v[j] = (f32x4){bflo(o.x), bfhi(o.x), bflo(o.y), bfhi(o.y)}; } } \
        if (HAS_H) { float ss = 0.f; \
            _Pragma("unroll") for (int j = 0; j < 4; ++j) ss += (v[j].x * v[j].x + v[j].y * v[j].y) + (v[j].z * v[j].z + v[j].w * v[j].w); \
            ss = wave_sum(ss); \
            const float r = rsqrtf(ss * (1.f / 1024.f) + 1e-6f); \
            const float* shift = modn + (size_t)ci * 9216 + sn * 1024; const float* scale = shift + 1024; \
            bf16_t* ho = H + (size_t)(t) * 1024; \
            _Pragma("unroll") for (int j = 0; j < 4; ++j) { const f32x4 sh = *(const f32x4*)(shift + 4 * lane + 256 * j), scl = *(const f32x4*)(scale + 4 * lane + 256 * j), gp = *(const f32x4*)(gpre + 4 * lane + 256 * j); \
                const f32x4 hv = (v[j] * r) * gp * (scl + 1.f) + sh; \
                u32x2 o; o.x = pk2(hv.x, hv.y); o.y = pk2(hv.z, hv.w); \
                *(u32x2*)(ho + 4 * lane + 256 * j) = o; } } } while (0)
        ROW_COMPUTE(tA, vA, yA, zA);
        if (hasB) ROW_COMPUTE(tB, vB, yB, zB);
#undef ROW_COMPUTE
    }
}

template <class SrcF>
DI void wave_transpose64(LAS unsigned short* scr, SrcF src, bf16_t* dst, size_t ldd, int lane) {
    const int lr = lane >> 3, ch = lane & 7;
    u32x4 v[8];
#pragma unroll
    for (int i = 0; i < 8; ++i) v[i] = src(8 * i + lr, ch);
#pragma unroll
    for (int i = 0; i < 8; ++i) { LAS unsigned* s = (LAS unsigned*)(scr + (8 * i + lr) * 66 + 8 * ch); s[0] = v[i].x; s[1] = v[i].y; s[2] = v[i].z; s[3] = v[i].w; }
    LDS_WAIT();
#pragma unroll
    for (int j = 0; j < 8; ++j) { const int d = lr + 8 * j; LAS const unsigned short* s = scr + (8 * ch) * 66 + d;
        u32x4 o;
        o.x = (unsigned)s[0 * 66] | ((unsigned)s[1 * 66] << 16); o.y = (unsigned)s[2 * 66] | ((unsigned)s[3 * 66] << 16);
        o.z = (unsigned)s[4 * 66] | ((unsigned)s[5 * 66] << 16); o.w = (unsigned)s[6 * 66] | ((unsigned)s[7 * 66] << 16);
        *(u32x4*)(dst + (size_t)d * ldd + 8 * ch) = o; }
    LDS_WAIT();
}
struct TItem { const void* src; size_t lds_; int f32; bf16_t* dst; size_t ldd; };
DI void titem_load(const TItem& d, u32x4 (&v)[8], int lane) {
    const int lr = lane >> 3, ch = lane & 7;
    if (d.f32) {
#pragma unroll
        for (int i = 0; i < 8; ++i) { const float* p = (const float*)d.src + (size_t)(8 * i + lr) * d.lds_ + 8 * ch; const f32x4 a = *(const f32x4*)p, b = *(const f32x4*)(p + 4);
            v[i].x = pk2(a.x, a.y); v[i].y = pk2(a.z, a.w); v[i].z = pk2(b.x, b.y); v[i].w = pk2(b.z, b.w); }
    } else {
#pragma unroll
        for (int i = 0; i < 8; ++i) v[i] = *(const u32x4*)((const bf16_t*)d.src + (size_t)(8 * i + lr) * d.lds_ + 8 * ch);
    }
}
DI void titem_finish(const TItem& d, const u32x4 (&v)[8], LAS unsigned short* scr, int lane) {
    const int lr = lane >> 3, ch = lane & 7;
#pragma unroll
    for (int i = 0; i < 8; ++i) { LAS unsigned* s = (LAS unsigned*)(scr + (8 * i + lr) * 66 + 8 * ch); s[0] = v[i].x; s[1] = v[i].y; s[2] = v[i].z; s[3] = v[i].w; }
    LDS_WAIT();
#pragma unroll
    for (int j = 0; j < 8; ++j) { const int dd = lr + 8 * j; LAS const unsigned short* s = scr + (8 * ch) * 66 + dd;
        u32x4 o;
        o.x = (unsigned)s[0 * 66] | ((unsigned)s[1 * 66] << 16); o.y = (unsigned)s[2 * 66] | ((unsigned)s[3 * 66] << 16);
        o.z = (unsigned)s[4 * 66] | ((unsigned)s[5 * 66] << 16); o.w = (unsigned)s[6 * 66] | ((unsigned)s[7 * 66] << 16);
        *(u32x4*)(d.dst + (size_t)dd * d.ldd + 8 * ch) = o; }
    LDS_WAIT();
}
DI u32x4 ld8_bf16(const bf16_t* p) { return *(const u32x4*)p; }
DI u32x4 ld8_f32(const float* p) { const f32x4 a = *(const f32x4*)p, b = *(const f32x4*)(p + 4); u32x4 o; o.x = pk2(a.x, a.y); o.y = pk2(a.z, a.w); o.z = pk2(b.x, b.y); o.w = pk2(b.z, b.w); return o; }

DI void phase_prep0(const Params& p, LAS unsigned char* lds) {
    const int tid = otid(), lane = tid & 63, wave = tid >> 6;
    const int gw = blockIdx.x * 8 + wave, NGW = gridDim.x * 8;
    bf16_t* P = (bf16_t*)(p.ws + WS_RB);
    unsigned char* RA = p.ws + WS_RA;
    bf16_t* rKt = (bf16_t*)(RA + RA_RKT); bf16_t* rVt = (bf16_t*)(RA + RA_RVT);
    bf16_t* gKc = (bf16_t*)(RA + RA_GKC); bf16_t* gKs = (bf16_t*)(RA + RA_GKS);
    bf16_t* gVtc = (bf16_t*)(RA + RA_GVTC); bf16_t* gVts = (bf16_t*)(RA + RA_GVTS);
    LAS float* rt = (LAS float*)lds;
    for (int e = tid; e < 1024; e += 512) { const int pos = e >> 4, i = e & 15; const float inv = powf(10000.f, -(float)i / 16.f); const float ang = (float)pos * inv;
        rt[e] = cosf(ang); rt[1024 + e] = sinf(ang); }
    __syncthreads();
    LAS unsigned short* scr = (LAS unsigned short*)(lds + 16384 + wave * 8704);
    constexpr int NA_ = 640 * 8, NB_ = 640 * 8, NC_ = 128 * 2, ND_ = 512 * 2, NE_ = 64, NTOT_ = NA_ + NB_ + NC_ + ND_ + NE_;
    auto item_of = [&](int it) {
        TItem d; d.f32 = 0; d.lds_ = 2816;
        int r = it;
        if (r < NA_ + NB_) { const int isv = r >= NA_; if (isv) r -= NA_; const int tb = r >> 3, h = r & 7, t0 = 64 * tb;
            d.src = P + (size_t)t0 * 2816 + (isv ? 1024 : 512) + 64 * h; d.dst = (isv ? rVt : rKt) + (size_t)(64 * h) * T + t0; d.ldd = (size_t)T; return d; }
        r -= NA_ + NB_;
        if (r < NC_) { const int tb = r >> 1, kvh = r & 1, t0 = 64 * tb, b = t0 >> 8;
            d.src = P + (size_t)t0 * 2816 + 2688 + 64 * kvh; d.dst = gVtc + (size_t)(b * 128 + 64 * kvh) * 256 + (t0 & 255); d.ldd = 256; return d; }
        r -= NC_;
        if (r < ND_) { const int tb = r >> 1, kvh = r & 1, n0g = 64 * tb, b = n0g >> 12, n0 = n0g & 4095;
            d.src = P + (size_t)(TC + n0g) * 2816 + 2688 + 64 * kvh; d.dst = gVts + (size_t)(b * 128 + 64 * kvh) * 4352 + n0; d.ldd = 4352; return d; }
        r -= ND_;
        { const int b = r >> 3, pb = (r >> 1) & 3, kvh = r & 1;
            d.src = p.in[3] + ((size_t)(b * 256 + 64 * pb) * 2 + kvh) * 64; d.lds_ = 128; d.f32 = 1; d.dst = gVts + (size_t)(b * 128 + 64 * kvh) * 4352 + 4096 + 64 * pb; d.ldd = 4352; return d; }
    };
    for (int it = gw; it < NTOT_; it += 2 * NGW) {
        const int it2 = it + NGW; const bool has2 = it2 < NTOT_;
        const TItem dA = item_of(it); const TItem dB = item_of(has2 ? it2 : it);
        u32x4 vA[8], vB[8];
        titem_load(dA, vA, lane);
        if (has2) titem_load(dB, vB, lane);
        titem_finish(dA, vA, scr, lane);
        if (has2) titem_finish(dB, vB, scr, lane);
    }
    for (int e8 = blockIdx.x * 512 + tid; e8 < 8 * 256 * 128 / 8; e8 += gridDim.x * 512) { const int e = e8 * 8, b = e >> 15, rem = e & 32767;
        *(u32x4*)(gKs + (size_t)(b * 4352 + 4096) * 128 + rem) = ld8_f32(p.in[2] + e); }
    const float* qn = p.in[21]; const float* kn = p.in[22];
    const int sub = lane & 7;
    float qnw[8], knw[8];
#pragma unroll
    for (int j = 0; j < 8; ++j) { qnw[j] = qn[8 * sub + j] * (0.125f * LOG2E); knw[j] = kn[8 * sub + j]; }
    u32x4 nq = (u32x4){0u, 0u, 0u, 0u}, nk = nq, nv = nq;
#define PREP_LOADRAW(t_) do { const bf16_t* pr_ = P + (size_t)(t_) * 2816; nq = *(const u32x4*)(pr_ + 2048 + 8 * lane); nk = *(const u32x4*)(pr_ + 2560 + 8 * (lane & 15)); nv = *(const u32x4*)(pr_ + 2688 + 8 * (lane & 15)); } while (0)
    if (gw < T) PREP_LOADRAW(gw);
    for (int t = gw; t < T; t += NGW) {
        bf16_t* pr = P + (size_t)t * 2816;
        const u32x4 rawq = nq, rawk = nk, rawv = nv;
        if (t + NGW < T) PREP_LOADRAW(t + NGW);
        const bool smp = t >= TC; const int n = (t - TC) & 4095, bb = (t - TC) >> 12;
        const int pos = (sub < 4) ? (n >> 6) : (n & 63);
        float cs[8], sn[8];
#pragma unroll
        for (int j = 0; j < 8; ++j) { const int i = 8 * (sub & 1) + j; cs[j] = rt[pos * 16 + i]; sn[j] = rt[1024 + pos * 16 + i]; }
        const bool isx2 = (sub >> 1) & 1;
        { const u32x4 raw = rawq;
          float v[8] = {bflo(raw.x), bfhi(raw.x), bflo(raw.y), bfhi(raw.y), bflo(raw.z), bfhi(raw.z), bflo(raw.w), bfhi(raw.w)};
          float ss = 0.f;
#pragma unroll
          for (int j = 0; j < 8; ++j) ss += v[j] * v[j];
          ss += __shfl_xor(ss, 1); ss += __shfl_xor(ss, 2); ss += __shfl_xor(ss, 4);
          const float rs = rsqrtf(ss * (1.f / 64.f) + 1e-6f);
#pragma unroll
          for (int j = 0; j < 8; ++j) v[j] = v[j] * rs * qnw[j];
          if (smp) {
#pragma unroll
              for (int j = 0; j < 8; ++j) { const float pv = __shfl_xor(v[j], 2); v[j] = isx2 ? (v[j] * cs[j] + pv * sn[j]) : (v[j] * cs[j] - pv * sn[j]); }
          }
          u32x4 o; o.x = pk2(v[0], v[1]); o.y = pk2(v[2], v[3]); o.z = pk2(v[4], v[5]); o.w = pk2(v[6], v[7]);
          *(u32x4*)(pr + 2048 + 8 * lane) = o; }
        { const u32x4 raw = rawk;
          float v[8] = {bflo(raw.x), bfhi(raw.x), bflo(raw.y), bfhi(raw.y), bflo(raw.z), bfhi(raw.z), bflo(raw.w), bfhi(raw.w)};
          float ss = 0.f;
#pragma unroll
          for (int j = 0; j < 8; ++j) ss += v[j] * v[j];
          ss += __shfl_xor(ss, 1); ss += __shfl_xor(ss, 2); ss += __shfl_xor(ss, 4);
          const float rs = rsqrtf(ss * (1.f / 64.f) + 1e-6f);
#pragma unroll
          for (int j = 0; j < 8; ++j) v[j] = v[j] * rs * knw[j];
          if (!smp) {
              if (lane < 16) {
                  float* ok = p.out + O_GK + (size_t)t * 128 + 8 * lane;
                  *(f32x4*)ok = (f32x4){v[0], v[1], v[2], v[3]}; *(f32x4*)(ok + 4) = (f32x4){v[4], v[5], v[6], v[7]};
                  u32x4 o; o.x = pk2(v[0], v[1]); o.y = pk2(v[2], v[3]); o.z = pk2(v[4], v[5]); o.w = pk2(v[6], v[7]);
                  *(u32x4*)(gKc + (size_t)t * 128 + 8 * lane) = o;
                  const u32x4 rv = rawv;
                  float* ov = p.out + O_GV + (size_t)t * 128 + 8 * lane;
                  *(f32x4*)ov = (f32x4){bflo(rv.x), bfhi(rv.x), bflo(rv.y), bfhi(rv.y)}; *(f32x4*)(ov + 4) = (f32x4){bflo(rv.z), bfhi(rv.z), bflo(rv.w), bfhi(rv.w)};
              }
          } else {
#pragma unroll
              for (int j = 0; j < 8; ++j) { const float pv = __shfl_xor(v[j], 2); v[j] = isx2 ? (v[j] * cs[j] + pv * sn[j]) : (v[j] * cs[j] - pv * sn[j]); }
              if (lane < 16) { u32x4 o; o.x = pk2(v[0], v[1]); o.y = pk2(v[2], v[3]); o.z = pk2(v[4], v[5]); o.w = pk2(v[6], v[7]);
                  *(u32x4*)(gKs + (size_t)(bb * 4352 + n) * 128 + 8 * lane) = o; }
          } }
    }
}

#undef PREP_LOADRAW
DI void phase_prep1(const Params& p, LAS unsigned char* lds) {
    const int tid = otid(), lane = tid & 63, wave = tid >> 6;
    const int gw = blockIdx.x * 8 + wave, NGW = gridDim.x * 8;
    const bf16_t* P = (const bf16_t*)(p.ws + WS_RB);
    unsigned char* RA = p.ws + WS_RA;
    bf16_t* nVt = (bf16_t*)(RA + RA_NVT); bf16_t* nKc = (bf16_t*)(RA + RA_NKC); bf16_t* nVtc = (bf16_t*)(RA + RA_NVTC);
    LAS unsigned short* scr = (LAS unsigned short*)(lds + wave * 8704);
    constexpr int NA_ = 640 * 16, NB_ = 8 * 4 * 16, NTOT_ = NA_ + NB_;
    auto item_of = [&](int it) {
        TItem d; d.f32 = 0; d.lds_ = 3072;
        int r = it;
        if (r < NA_) { const int tb = r >> 4, hd = r & 15, t0 = 64 * tb;
            d.src = P + (size_t)t0 * 3072 + 2048 + 64 * hd; d.dst = nVt + (size_t)(64 * hd) * T + t0; d.ldd = (size_t)T; return d; }
        r -= NA_;
        { const int b = r >> 6, pb = (r >> 4) & 3, hd = r & 15;
            d.src = p.in[7] + ((size_t)(b * 256 + 64 * pb) * 16 + hd) * 64; d.lds_ = 1024; d.f32 = 1; d.dst = nVtc + (size_t)(b * 1024 + 64 * hd) * 256 + 64 * pb; d.ldd = 256; return d; }
    };
    for (int it = gw; it < NTOT_; it += 2 * NGW) {
        const int it2 = it + NGW; const bool has2 = it2 < NTOT_;
        const TItem dA = item_of(it); const TItem dB = item_of(has2 ? it2 : it);
        u32x4 vA[8], vB[8];
        titem_load(dA, vA, lane);
        if (has2) titem_load(dB, vB, lane);
        titem_finish(dA, vA, scr, lane);
        if (has2) titem_finish(dB, vB, scr, lane);
    }
    for (int e8 = blockIdx.x * 512 + tid; e8 < 8 * 256 * 1024 / 8; e8 += gridDim.x * 512) *(u32x4*)(nKc + (size_t)e8 * 8) = ld8_f32(p.in[6] + (size_t)e8 * 8);
#pragma unroll 4
    for (int e = blockIdx.x * 512 + tid; e < TC * 256; e += gridDim.x * 512) { const int t = e >> 8, c8 = (e & 255) * 8;
        const u32x4 rv = *(const u32x4*)(P + (size_t)t * 3072 + 1024 + c8);
        float* o = (c8 < 1024) ? p.out + O_NK + (size_t)t * 1024 + c8 : p.out + O_NV + (size_t)t * 1024 + (c8 - 1024);
        *(f32x4*)o = (f32x4){bflo(rv.x), bfhi(rv.x), bflo(rv.y), bfhi(rv.y)}; *(f32x4*)(o + 4) = (f32x4){bflo(rv.z), bfhi(rv.z), bflo(rv.w), bfhi(rv.w)}; }
}

DI float log2_sigmoid(float x) { return -log1pf(expf(-x)) * LOG2E; }

DI void phase_r1(const Params& p) {
    const int tid = otid(), lane = tid & 63, wave = tid >> 6, r = lane & 31, hh = lane >> 5;
    const int gw = blockIdx.x * 8 + wave, NGW = gridDim.x * 8;
    unsigned char* RA = p.ws + WS_RA;
    const bf16_t* rKt = (const bf16_t*)(RA + RA_RKT); const bf16_t* rVt = (const bf16_t*)(RA + RA_RVT);
    float* KVs = (float*)(RA + RA_KVS);
    for (int it = gw; it < 160 * 8 * 2; it += NGW) {
        const int dir = it & 1, cidx = it >> 4, h = (it >> 1) & 7, t0 = 256 * cidx;
        const bool ctx = cidx < 32;
        const float l2 = log2_sigmoid(p.in[dir ? 19 : 18][h]);
        const float wa = dir ? 0.f : 255.f, ws = dir ? 1.f : -1.f;
        f32x16 acc[2][2];
#pragma unroll
        for (int a = 0; a < 2; ++a)
#pragma unroll
            for (int b = 0; b < 2; ++b)
#pragma unroll
                for (int i = 0; i < 16; ++i) acc[a][b][i] = 0.f;
        const bf16_t* vb = rVt + (size_t)(64 * h + r) * T + t0 + 8 * hh;
        const bf16_t* kb = rKt + (size_t)(64 * h + r) * T + t0 + 8 * hh;
#pragma unroll 2
        for (int ks = 0; ks < 16; ++ks) {
            const int j0 = 16 * ks + 8 * hh;
            bf16x8 aV[2], bK[2];
            float wj[8];
#pragma unroll
            for (int jj = 0; jj < 8; ++jj) wj[jj] = 0.125f * fexp2((wa + ws * (float)(j0 + jj)) * l2);
#pragma unroll
            for (int blk = 0; blk < 2; ++blk) {
                aV[blk] = *(const bf16x8*)(vb + (size_t)(32 * blk) * T + 16 * ks);
                const u32x4 kr = *(const u32x4*)(kb + (size_t)(32 * blk) * T + 16 * ks);
                u32x4 ow;
                ow.x = pk2(bflo(kr.x) * wj[0], bfhi(kr.x) * wj[1]); ow.y = pk2(bflo(kr.y) * wj[2], bfhi(kr.y) * wj[3]);
                ow.z = pk2(bflo(kr.z) * wj[4], bfhi(kr.z) * wj[5]); ow.w = pk2(bflo(kr.w) * wj[6], bfhi(kr.w) * wj[7]);
                bK[blk] = __builtin_bit_cast(bf16x8, ow);
            }
#pragma unroll
            for (int a = 0; a < 2; ++a)
#pragma unroll
                for (int b = 0; b < 2; ++b) {
                    const bf16x8 Af = ctx ? bK[a] : aV[a], Bf = ctx ? aV[b] : bK[b];
                    acc[a][b] = MFMA32(Af, Bf, acc[a][b]);
                }
        }
        float* od;
        if (ctx) od = p.out + (dir ? O_RB : O_RF) + (size_t)(cidx * 8 + h) * 4096;
        else { const int bc = cidx - 32, b = bc >> 4, c = bc & 15; od = KVs + ((size_t)((b * 8 + h) * 16 + c) * 2 + dir) * 4096; }
#pragma unroll
        for (int a = 0; a < 2; ++a)
#pragma unroll
            for (int b = 0; b < 2; ++b)
#pragma unroll
                for (int i = 0; i < 16; ++i) od[(32 * a + crow(i, hh)) * 64 + 32 * b + r] = acc[a][b][i];
    }
}
DI void phase_r2(const Params& p) {
    unsigned char* RA = p.ws + WS_RA;
    const float* KVs = (const float*)(RA + RA_KVS); bf16_t* FB = (bf16_t*)(RA + RA_FB);
    const int tid2 = otid();
    for (int e = blockIdx.x * 512 + tid2; e < 64 * 2 * 4096; e += gridDim.x * 512) {
        const int bh = e >> 13, dir = (e >> 12) & 1, el = e & 4095, dv = el >> 6, dk = el & 63, h = bh & 7;
        const float l2 = log2_sigmoid(p.in[dir ? 19 : 18][h]);
        const float gC = fexp2(256.f * l2);
        float S = p.in[dir ? 5 : 4][(size_t)bh * 4096 + dk * 64 + dv];
        if (dir == 0) { for (int c = 0; c < 16; ++c) { const size_t o = ((size_t)(bh * 16 + c) * 2) * 4096 + el; FB[o] = f2bf(S); S = gC * S + KVs[o]; } }
        else { for (int c = 15; c >= 0; --c) { const size_t o = ((size_t)(bh * 16 + c) * 2 + 1) * 4096 + el; FB[o] = f2bf(S); S = gC * S + KVs[o]; } }
    }
}

enum { MODE_SOFTMAX = 0, MODE_NA = 1, MODE_RET = 2 };
struct AttnUnit {
    const bf16_t* q; int ldq; bf16_t* o; int ldo;
    const bf16_t* k0; int ldk0; const bf16_t* vt0; int ldvt0; int nt0;
    const bf16_t* k1; int ldk1; const bf16_t* vt1; int ldvt1; int nt;
    float sc;
    int r_unit0, rlo;
    float l2f, l2b; const bf16_t* FB; const float* gn;
};
template <int MODE>
DI void attn_unit(LAS unsigned char* lds, const AttnUnit& U, LAS const float* rpbs) {
    const int tid = otid(), lane = tid & 63, w = __builtin_amdgcn_readfirstlane(tid >> 6), qi = lane & 31, hh = lane >> 5;
    const bf16_t* qrow = U.q + (size_t)(32 * w + qi) * U.ldq + 8 * hh;
    bf16x8 bq[4];
#pragma unroll
    for (int ks = 0; ks < 4; ++ks) bq[ks] = *(const bf16x8*)(qrow + 16 * ks);
    f32x16 o0, o1;
#pragma unroll
    for (int i = 0; i < 16; ++i) { o0[i] = 0.f; o1[i] = 0.f; }
    float m_run = -INFINITY, l_run = 0.f;
    const int sr = tid >> 3, scol = (tid & 7) * 8;
    const unsigned stoff = (unsigned)(sr * 72 + scol) * 2u;
    const unsigned vstoffA = (unsigned)(sr * 72 + 16 * ((tid & 7) >> 1) + 4 * (tid & 1)) * 2u;
    u32x4 kreg, vreg;
    const int nr = U.r_unit0 + (w >> 1), ncq = 32 * (w & 1) + qi;
    const int nr0 = min(max(nr - 4, 0), 56), nc0 = min(max(ncq - 8, 0), 48);
    const int iq = 32 * w + qi;
#define ATT_LOAD(t) do { const bf16_t *kp, *vp; if ((t) < U.nt0) { kp = U.k0 + (size_t)(64 * (t) + sr) * U.ldk0 + scol; vp = U.vt0 + (size_t)sr * U.ldvt0 + 64 * (t) + scol; } \
        else { const int t1 = (t) - U.nt0; kp = U.k1 + (size_t)(64 * t1 + sr) * U.ldk1 + scol; vp = U.vt1 + (size_t)sr * U.ldvt1 + 64 * t1 + scol; } \
        kreg = *(const u32x4*)kp; vreg = *(const u32x4*)vp; } while (0)
#define ATT_WRITE(b) do { *(LAS u32x4*)(lds + (b) * 18432 + stoff) = kreg; \
        *(LAS u32x2*)(lds + (b) * 18432 + 9216 + vstoffA) = (u32x2){vreg.x, vreg.y}; *(LAS u32x2*)(lds + (b) * 18432 + 9216 + vstoffA + 16) = (u32x2){vreg.z, vreg.w}; } while (0)
    __syncthreads();
    ATT_LOAD(0); ATT_WRITE(0);
    __syncthreads();
    for (int t = 0; t < U.nt; ++t) {
        const int cur = t & 1;
        if (t + 1 < U.nt) ATT_LOAD(t + 1);
        bool active = true; int dr = 0; bool win = false;
        if (MODE == MODE_NA) { win = t < U.nt0; if (win) { const int kr = U.rlo + t; active = (kr >= nr0) && (kr < nr0 + 8); dr = kr - nr + 7; } }
        if (active) {
            LAS const unsigned char* Kb = lds + cur * 18432; LAS const unsigned char* Vb = Kb + 9216;
            f32x16 s0, s1;
#pragma unroll
            for (int i = 0; i < 16; ++i) { s0[i] = 0.f; s1[i] = 0.f; }
#pragma unroll
            for (int ks = 0; ks < 4; ++ks) {
                const bf16x8 a0 = *(LAS const bf16x8*)(Kb + (qi * 72 + 16 * ks + 8 * hh) * 2);
                const bf16x8 a1 = *(LAS const bf16x8*)(Kb + ((32 + qi) * 72 + 16 * ks + 8 * hh) * 2);
                s0 = MFMA32(a0, bq[ks], s0); s1 = MFMA32(a1, bq[ks], s1);
            }
            if (MODE == MODE_RET) {
#pragma unroll
                for (int i = 0; i < 16; ++i) {
                    const int j0 = 64 * t + crow(i, hh), j1 = j0 + 32;
                    const int d0 = iq - j0, d1 = iq - j1;
                    const float w0 = 0.125f * fexp2(d0 >= 0 ? (float)d0 * U.l2f : (float)(-d0) * U.l2b);
                    const float w1 = 0.125f * fexp2(d1 >= 0 ? (float)d1 * U.l2f : (float)(-d1) * U.l2b);
                    s0[i] *= w0; s1[i] *= w1;
                }
            } else {
                if (MODE == MODE_NA && win) {
                    LAS const float* bp = rpbs + dr * 31 + 15 - ncq;
#pragma unroll
                    for (int i = 0; i < 16; ++i) {
                        const int kc0 = crow(i, hh), kc1 = kc0 + 32;
                        const bool v0 = (unsigned)(kc0 - nc0) < 16u, v1 = (unsigned)(kc1 - nc0) < 16u;
                        const float b0 = v0 ? bp[kc0] : 0.f, b1 = v1 ? bp[kc1] : 0.f;
                        s0[i] = v0 ? s0[i] + b0 : -INFINITY; s1[i] = v1 ? s1[i] + b1 : -INFINITY;
                    }
                }
                float mx = fmaxf(s0[0], s1[0]);
#pragma unroll
                for (int i = 1; i < 16; ++i) mx = fmaxf(fmaxf(mx, s0[i]), s1[i]);
                { const unsigned mu = __float_as_uint(mx); auto r2 = __builtin_amdgcn_permlane32_swap(mu, mu, false, false); mx = fmaxf(__uint_as_float(r2[0]), __uint_as_float(r2[1])); }
                const bool upd = mx > m_run + 8.f;
                if (__builtin_amdgcn_ballot_w64(upd) != 0ull) {
                    const float mn = upd ? mx : m_run;
                    const float alpha = fexp2(m_run - mn);
                    m_run = mn; l_run *= alpha;
#pragma unroll
                    for (int i = 0; i < 16; ++i) { o0[i] *= alpha; o1[i] *= alpha; }
                }
                const f32x2 mm = (f32x2){m_run, m_run};
                f32x2 ps2 = (f32x2){0.f, 0.f};
#pragma unroll
                for (int i = 0; i < 8; ++i) {
                    const f32x2 t0 = (f32x2){s0[2 * i], s0[2 * i + 1]} - mm, t1 = (f32x2){s1[2 * i], s1[2 * i + 1]} - mm;
                    s0[2 * i] = fexp2(t0.x); s0[2 * i + 1] = fexp2(t0.y); s1[2 * i] = fexp2(t1.x); s1[2 * i + 1] = fexp2(t1.y);
                    ps2 += (f32x2){s0[2 * i], s0[2 * i + 1]}; ps2 += (f32x2){s1[2 * i], s1[2 * i + 1]};
                }
                l_run += ps2.x + ps2.y;
            }
#pragma unroll
            for (int kb = 0; kb < 2; ++kb)
#pragma unroll
                for (int s = 0; s < 2; ++s) {
                    u32x4 pw;
                    if (kb == 0) { pw.x = pk2(s0[8 * s], s0[8 * s + 1]); pw.y = pk2(s0[8 * s + 2], s0[8 * s + 3]); pw.z = pk2(s0[8 * s + 4], s0[8 * s + 5]); pw.w = pk2(s0[8 * s + 6], s0[8 * s + 7]); }
                    else { pw.x = pk2(s1[8 * s], s1[8 * s + 1]); pw.y = pk2(s1[8 * s + 2], s1[8 * s + 3]); pw.z = pk2(s1[8 * s + 4], s1[8 * s + 5]); pw.w = pk2(s1[8 * s + 6], s1[8 * s + 7]); }
                    const bf16x8 pb = __builtin_bit_cast(bf16x8, pw);
                    const int koff = (32 * kb + 16 * s + 8 * hh) * 2;
                    const bf16x8 aV0 = *(LAS const bf16x8*)(Vb + (qi * 72) * 2 + koff);
                    const bf16x8 aV1 = *(LAS const bf16x8*)(Vb + ((32 + qi) * 72) * 2 + koff);
                    o0 = MFMA32(aV0, pb, o0); o1 = MFMA32(aV1, pb, o1);
                }
        }
        if (t + 1 < U.nt) ATT_WRITE(cur ^ 1);
        __syncthreads();
    }
#undef ATT_LOAD
#undef ATT_WRITE
    bf16_t* orow = U.o + (size_t)(32 * w + qi) * U.ldo;
    if (MODE == MODE_RET) {
        if (U.FB) {
            f32x16 c0, c1, e0, e1;
#pragma unroll
            for (int i = 0; i < 16; ++i) { c0[i] = 0.f; c1[i] = 0.f; e0[i] = 0.f; e1[i] = 0.f; }
            const bf16_t* Fp = U.FB + (size_t)qi * 64 + 8 * hh; const bf16_t* Bp = Fp + 4096;
#pragma unroll
            for (int ks = 0; ks < 4; ++ks) {
                const bf16x8 f0 = *(const bf16x8*)(Fp + 16 * ks), f1 = *(const bf16x8*)(Fp + 2048 + 16 * ks);
                const bf16x8 g0 = *(const bf16x8*)(Bp + 16 * ks), g1 = *(const bf16x8*)(Bp + 2048 + 16 * ks);
                c0 = MFMA32(f0, bq[ks], c0); c1 = MFMA32(f1, bq[ks], c1); e0 = MFMA32(g0, bq[ks], e0); e1 = MFMA32(g1, bq[ks], e1);
            }
            const float wf = fexp2((float)(iq + 1) * U.l2f), wb = fexp2((float)(256 - iq) * U.l2b);
#pragma unroll
            for (int i = 0; i < 16; ++i) { o0[i] += wf * c0[i] + wb * e0[i]; o1[i] += wf * c1[i] + wb * e1[i]; }
        }
        float s = 0.f;
#pragma unroll
        for (int i = 0; i < 16; ++i) s += o0[i] + o1[i];
        s += __shfl_xor(s, 32);
        const float mu = s * (1.f / 64.f);
        float vs = 0.f;
#pragma unroll
        for (int i = 0; i < 16; ++i) { const float a = o0[i] - mu, b = o1[i] - mu; vs += a * a + b * b; }
        vs += __shfl_xor(vs, 32);
        const float rstd = rsqrtf(vs * (1.f / 64.f) + 1e-5f);
#pragma unroll
        for (int db = 0; db < 2; ++db)
#pragma unroll
            for (int g = 0; g < 4; ++g) { const int d = 32 * db + 8 * g + 4 * hh;
                const u32x2 graw = *(const u32x2*)(orow + d);
                const f32x4 gw = *(const f32x4*)(U.gn + d);
                const float g0 = silu_f(bflo(graw.x)), g1 = silu_f(bfhi(graw.x)), g2 = silu_f(bflo(graw.y)), g3 = silu_f(bfhi(graw.y));
                const float x0 = (db ? o1[4 * g] : o0[4 * g]), x1 = (db ? o1[4 * g + 1] : o0[4 * g + 1]), x2 = (db ? o1[4 * g + 2] : o0[4 * g + 2]), x3 = (db ? o1[4 * g + 3] : o0[4 * g + 3]);
                u32x2 ov; ov.x = pk2((x0 - mu) * rstd * gw.x * g0, (x1 - mu) * rstd * gw.y * g1); ov.y = pk2((x2 - mu) * rstd * gw.z * g2, (x3 - mu) * rstd * gw.w * g3);
                *(u32x2*)(orow + d) = ov; }
    } else {
        float l; { const unsigned lu = __float_as_uint(l_run); auto r2 = __builtin_amdgcn_permlane32_swap(lu, lu, false, false); l = __uint_as_float(r2[0]) + __uint_as_float(r2[1]); }
        const float inv = 1.f / l;
#pragma unroll
        for (int db = 0; db < 2; ++db)
#pragma unroll
            for (int g = 0; g < 4; ++g) { const int d = 32 * db + 8 * g + 4 * hh;
                const float x0 = (db ? o1[4 * g] : o0[4 * g]), x1 = (db ? o1[4 * g + 1] : o0[4 * g + 1]), x2 = (db ? o1[4 * g + 2] : o0[4 * g + 2]), x3 = (db ? o1[4 * g + 3] : o0[4 * g + 3]);
                u32x2 ov; ov.x = pk2(x0 * inv, x1 * inv); ov.y = pk2(x2 * inv, x3 * inv);
                *(u32x2*)(orow + d) = ov; }
    }
}

DI void phase_att0(const Params& p, LAS unsigned char* lds, bool dummy = false) {
    bf16_t* P = (bf16_t*)(p.ws + WS_RB);
    unsigned char* RA = p.ws + WS_RA;
    const bf16_t* rVt = (const bf16_t*)(RA + RA_RVT);
    const bf16_t* gKc = (const bf16_t*)(RA + RA_GKC); const bf16_t* gKs = (const bf16_t*)(RA + RA_GKS);
    const bf16_t* gVtc = (const bf16_t*)(RA + RA_GVTC); const bf16_t* gVts = (const bf16_t*)(RA + RA_GVTS);
    const bf16_t* FB = (const bf16_t*)(RA + RA_FB);
    for (int u = blockIdx.x; u < 2560; u += gridDim.x) {
        AttnUnit U;
        U.k1 = nullptr; U.vt1 = nullptr; U.ldk1 = 0; U.ldvt1 = 0; U.r_unit0 = 0; U.rlo = 0; U.l2f = 0.f; U.l2b = 0.f; U.FB = nullptr; U.gn = nullptr;
        U.sc = 0.125f * LOG2E;
        if (u < 1024) {
            int b, kvh, rem2;
            if (gridDim.x == 256) { const int x = blockIdx.x & 7, slot = blockIdx.x >> 3, k = u >> 8, set = x + 8 * (k >> 1); b = set >> 1; kvh = set & 1; rem2 = (k & 1) * 32 + slot; }
            else { b = u >> 7; const int rem = u & 127; kvh = rem >> 6; rem2 = rem & 63; }
            const int qh = 4 * kvh + (rem2 >> 4), qb = rem2 & 15;
            U.q = P + (size_t)(TC + b * 4096 + qb * 256) * 2816 + 2048 + 64 * qh; U.ldq = 2816; U.o = (bf16_t*)U.q; U.ldo = 2816;
            U.k0 = gKs + (size_t)b * 4352 * 128 + 64 * kvh; U.ldk0 = 128; U.vt0 = gVts + (size_t)(b * 128 + 64 * kvh) * 4352; U.ldvt0 = 4352; U.nt0 = 68; U.nt = 68;
            if (dummy) { U.o = (bf16_t*)(p.ws + WS_END); U.ldo = 64; }
            attn_unit<MODE_SOFTMAX>(lds, U, nullptr);
        } else if (u < 1280) {
            const int v = u - 1024, b = v >> 3, qh = v & 7, kvh = qh >> 2;
            U.q = P + (size_t)(b * 256) * 2816 + 2048 + 64 * qh; U.ldq = 2816; U.o = (bf16_t*)U.q; U.ldo = 2816;
            U.k0 = gKc + (size_t)b * 256 * 128 + 64 * kvh; U.ldk0 = 128; U.vt0 = gVtc + (size_t)(b * 128 + 64 * kvh) * 256; U.ldvt0 = 256; U.nt0 = 4; U.nt = 4;
            if (dummy) { U.o = (bf16_t*)(p.ws + WS_END); U.ldo = 64; }
            attn_unit<MODE_SOFTMAX>(lds, U, nullptr);
        } else {
            const int v = u - 1280, cidx = v >> 3, h = v & 7, t0 = 256 * cidx;
            U.q = P + (size_t)t0 * 2816 + 64 * h; U.ldq = 2816; U.o = P + (size_t)t0 * 2816 + 1536 + 64 * h; U.ldo = 2816;
            U.k0 = P + (size_t)t0 * 2816 + 512 + 64 * h; U.ldk0 = 2816; U.vt0 = rVt + (size_t)(64 * h) * T + t0; U.ldvt0 = T; U.nt0 = 4; U.nt = 4;
            U.l2f = log2_sigmoid(p.in[18][h]); U.l2b = log2_sigmoid(p.in[19][h]); U.gn = p.in[20] + 64 * h;
            if (cidx >= 32) { const int bc = cidx - 32, b = bc >> 4, c = bc & 15; U.FB = FB + ((size_t)((b * 8 + h) * 16 + c) * 2) * 4096; }
            if (dummy) { U.o = (bf16_t*)(p.ws + WS_END); U.ldo = 64; }
            attn_unit<MODE_RET>(lds, U, nullptr);
        }
    }
}
DI void phase_att1(const Params& p, LAS unsigned char* lds, bool dummy = false) {
    bf16_t* P = (bf16_t*)(p.ws + WS_RB);
    unsigned char* RA = p.ws + WS_RA;
    const bf16_t* nVt = (const bf16_t*)(RA + RA_NVT); const bf16_t* nKc = (const bf16_t*)(RA + RA_NKC); const bf16_t* nVtc = (const bf16_t*)(RA + RA_NVTC);
    LAS float* rpbs = (LAS float*)(lds + 40960);
    for (int u = blockIdx.x; u < 2560; u += gridDim.x) {
        AttnUnit U;
        U.l2f = 0.f; U.l2b = 0.f; U.FB = nullptr; U.gn = nullptr; U.sc = 0.125f * LOG2E;
        if (u < 2048) {
            int b, hd, rg;
            if (gridDim.x == 256) { const int x = blockIdx.x & 7, slot = blockIdx.x >> 3, j = (u >> 8) * 32 + slot, pair = 16 * x + (j >> 4); b = pair >> 4; hd = pair & 15; rg = j & 15; }
            else { b = u >> 8; hd = (u >> 4) & 15; rg = u & 15; }
            const int rlo = min(max(4 * rg - 4, 0), 56), rhi0 = min(max(4 * rg - 1, 0), 56), nwin = rhi0 + 8 - rlo;
            const int tb = TC + b * 4096;
            __syncthreads();
            for (int e = otid(); e < 465; e += 512) rpbs[e] = p.in[25][(size_t)hd * 465 + e] * LOG2E;
            U.q = P + (size_t)(tb + 256 * rg) * 3072 + 64 * hd; U.ldq = 3072; U.o = (bf16_t*)U.q; U.ldo = 3072;
            U.k0 = P + (size_t)(tb + 64 * rlo) * 3072 + 1024 + 64 * hd; U.ldk0 = 3072; U.vt0 = nVt + (size_t)(64 * hd) * T + tb + 64 * rlo; U.ldvt0 = T; U.nt0 = nwin;
            U.k1 = nKc + (size_t)(b * 256) * 1024 + 64 * hd; U.ldk1 = 1024; U.vt1 = nVtc + (size_t)(b * 1024 + 64 * hd) * 256; U.ldvt1 = 256; U.nt = nwin + 4;
            U.r_unit0 = 4 * rg; U.rlo = rlo;
            if (dummy) { U.o = (bf16_t*)(p.ws + WS_END); U.ldo = 64; }
            attn_unit<MODE_NA>(lds, U, rpbs);
        } else {
            const int v = u - 2048, b = v >> 4, hd = v & 15;
            U.k1 = nullptr; U.vt1 = nullptr; U.ldk1 = 0; U.ldvt1 = 0; U.r_unit0 = 0; U.rlo = 0;
            U.q = P + (size_t)(b * 256) * 3072 + 64 * hd; U.ldq = 3072; U.o = (bf16_t*)U.q; U.ldo = 3072;
            U.k0 = P + (size_t)(b * 256) * 3072 + 1024 + 64 * hd; U.ldk0 = 3072; U.vt0 = nVt + (size_t)(64 * hd) * T + b * 256; U.ldvt0 = T; U.nt0 = 4; U.nt = 4;
            if (dummy) { U.o = (bf16_t*)(p.ws + WS_END); U.ldo = 64; }
            attn_unit<MODE_SOFTMAX>(lds, U, nullptr);
        }
    }
}

__global__ void __launch_bounds__(512, 2) fwd_megakernel(Params p) {
    extern __shared__ __attribute__((aligned(16))) unsigned char lds_raw[];
    LAS unsigned char* lds = (LAS unsigned char*)lds_raw;
    cg::grid_group grid = cg::this_grid();
    const int G = gridDim.x;
    float* X = p.out;
    float* mod = (float*)(p.ws + WS_MOD);
    bf16_t* H = (bf16_t*)(p.ws + WS_H); bf16_t* Y = (bf16_t*)(p.ws + WS_Y); bf16_t* PB = (bf16_t*)(p.ws + WS_RB); bf16_t* Y2 = (bf16_t*)(p.ws + WS_END);
    const float* npre = p.in[12]; const float* npost = p.in[13];
    unsigned* barw = (unsigned*)(p.ws + WS_CTL);
    if (blockIdx.x == 0) for (int e = threadIdx.x; e < XCD_BAR_WORDS; e += 512) barw[e] = 0u;
    if (threadIdx.x < 4) ((LAS unsigned*)(lds + 131072))[threadIdx.x] = 0u;
    __syncthreads();
    XcdBarrier xbar; xbar.bar = barw; xbar.x = 0; xbar.st = (volatile LAS unsigned*)(lds + 131072);
#define SYNC() xcd_barrier(xbar)
#define GEMM(Aptr, lda_, Bptr, N_, K_, EPI) do { g8::Gemm g{Aptr, lda_, Bptr, T, N_, K_}; g8::StaticOrder S; S.init(T, N_, K_, G, (int)blockIdx.x); g8::gemm_phase(lds, g, S, EPI); } while (0)
#define GEMM_Y(Aptr, lda_, Bptr, K_) do { g8::Gemm g{Aptr, lda_, Bptr, T, 1024, K_}; g8::SplitOrder S; S.init(K_, (int)blockIdx.x); g8::gemm_phase(lds, g, S, (g8::EpiBf16{Y, 1024, Y2})); } while (0)

    phase_mod(p.in[8], p.in[9], p.in[10], p.in[11], mod, (LAS float*)lds);
    phase_weights(p, lds);
    grid.sync();
    xbar = xcd_barrier_post(barw, (volatile LAS unsigned*)(lds + 131072));
    for (int l = 0; l < 2; ++l) {
        const float* modl = mod + (size_t)l * 9 * 9216;
        if (l == 0) row_phase<false, true, 0, 0>(p.in[0], p.in[1], X, nullptr, nullptr, H, nullptr, 0, 0.f, nullptr, modl, 0, npre + (l * 3 + 0) * 1024);
        else row_phase<true, true, 1, 1>(nullptr, nullptr, X, Y, Y2, H, mod, 8, 0.5f, npost + (0 * 3 + 2) * 1024, modl, 0, npre + (l * 3 + 0) * 1024);
        SYNC();
        GEMM(H, 1024, (const bf16_t*)(p.ws + WS_FIN + (size_t)(l * 2 + 0) * SZ_FIN), 5632, 1024, (g8::EpiSwiGLU{PB}));
        SYNC();
        GEMM_Y(PB, DFF, (const bf16_t*)(p.ws + WS_FOUT + (size_t)(l * 2 + 0) * SZ_FOUT), DFF);
        SYNC();
        if (l == 0) row_phase<true, true, 0, 1>(p.in[0], p.in[1], X, Y, Y2, H, modl, 2, 0.5f, npost + (l * 3 + 0) * 1024, modl, 3, npre + (l * 3 + 1) * 1024);
        else row_phase<true, true, 1, 1>(nullptr, nullptr, X, Y, Y2, H, modl, 2, 0.5f, npost + (l * 3 + 0) * 1024, modl, 3, npre + (l * 3 + 1) * 1024);
        SYNC();
        if (l == 0) {
            GEMM(H, 1024, (const bf16_t*)(p.ws + WS_ABIN), 2816, 1024, (g8::EpiBf16{PB, 2816}));
            SYNC();
            phase_prep0(p, lds);
            SYNC();
            phase_r1(p);
            SYNC();
            phase_r2(p);
            SYNC();
            if (PROBE & 2) { phase_att0(p, lds, true); SYNC(); }
            phase_att0(p, lds);
            SYNC();
            GEMM_Y(PB + 1536, 2816, (const bf16_t*)(p.ws + WS_ABOUT), 1024);
        } else {
            GEMM(H, 1024, (const bf16_t*)(p.ws + WS_NAQKV), 3072, 1024, (g8::EpiBf16{PB, 3072}));
            SYNC();
            phase_prep1(p, lds);
            SYNC();
            if (PROBE & 2) { phase_att1(p, lds, true); SYNC(); }
            phase_att1(p, lds);
            SYNC();
            GEMM_Y(PB, 3072, (const bf16_t*)(p.ws + WS_NAOUT), 1024);
        }
        SYNC();
        row_phase<true, true, 1, 1>(nullptr, nullptr, X, Y, Y2, H, modl, 5, 1.0f, npost + (l * 3 + 1) * 1024, modl, 6, npre + (l * 3 + 2) * 1024);
        SYNC();
        GEMM(H, 1024, (const bf16_t*)(p.ws + WS_FIN + (size_t)(l * 2 + 1) * SZ_FIN), 5632, 1024, (g8::EpiSwiGLU{PB}));
        SYNC();
        GEMM_Y(PB, DFF, (const bf16_t*)(p.ws + WS_FOUT + (size_t)(l * 2 + 1) * SZ_FOUT), DFF);
        SYNC();
    }
    row_phase<true, false, 1, 2>(nullptr, nullptr, X, Y, Y2, nullptr, mod + (size_t)9 * 9216, 8, 0.5f, npost + (1 * 3 + 2) * 1024, nullptr, 0, nullptr);
}

extern "C" void kernel_launch(void* const* d_in, const int* in_sizes, int n_in, void* d_out, int out_size, void* d_ws, size_t ws_size, hipStream_t stream) {
    static int grid = 0;
    if (grid == 0) {
        int dev = 0, cus = 0, per_cu = 0;
        hipGetDevice(&dev);
        hipDeviceGetAttribute(&cus, hipDeviceAttributeMultiprocessorCount, dev);
        if (hipFuncSetAttribute((const void*)fwd_megakernel, hipFuncAttributeMaxDynamicSharedMemorySize, LDS_BYTES) != hipSuccess) fprintf(stderr, "kernel_launch: hipFuncSetAttribute failed\n");
        hipOccupancyMaxActiveBlocksPerMultiprocessor(&per_cu, (const void*)fwd_megakernel, 512, LDS_BYTES);
        (void)hipGetLastError();
        if (per_cu < 1) { fprintf(stderr, "kernel_launch: occupancy query says %d blocks/CU\n", per_cu); per_cu = 1; }
        grid = cus;
        if (ws_size < WS_END) fprintf(stderr, "kernel_launch: workspace too small: %zu < %zu\n", ws_size, (size_t)WS_END);
        if (n_in != 26) fprintf(stderr, "kernel_launch: expected 26 inputs, got %d\n", n_in);
    }
    Params p{};
    for (int i = 0; i < 26; ++i) p.in[i] = (const float*)d_in[i];
    p.out = (float*)d_out; p.ws = (unsigned char*)d_ws;
    void* args[] = {&p};
    hipError_t e = hipLaunchCooperativeKernel((const void*)fwd_megakernel, dim3(grid), dim3(512), args, LDS_BYTES, stream);
    if (e != hipSuccess) fprintf(stderr, "cooperative launch failed: %s (grid %d)\n", hipGetErrorString(e), grid);
}
```

```cpp
#include <hip/hip_runtime.h>
#include <hip/hip_cooperative_groups.h>
#include <cstdio>
#include <cstdint>
namespace cg = cooperative_groups;

#define LAS __attribute__((address_space(3)))
#define DI __device__ __forceinline__
typedef unsigned short bf16_t;
typedef short bf16x8 __attribute__((ext_vector_type(8)));
typedef float f32x4 __attribute__((ext_vector_type(4)));
typedef float f32x2 __attribute__((ext_vector_type(2)));
typedef float f32x16 __attribute__((ext_vector_type(16)));
typedef unsigned u32x4 __attribute__((ext_vector_type(4)));
typedef unsigned u32x2 __attribute__((ext_vector_type(2)));
typedef __bf16 bf16x2_t __attribute__((ext_vector_type(2)));

#ifndef PROBE
#define PROBE 0
#endif
constexpr int T = 40960, TC = 8192, D = 1024, DFF = 2816;
constexpr int LDS_BYTES = 131072 + 16;
constexpr float LOG2E = 1.4426950408889634f;
constexpr size_t O_GK = 41943040, O_GV = 42991616, O_RF = 44040192, O_RB = 45088768, O_NK = 46137344, O_NV = 54525952;
constexpr size_t WS_MOD = 0;
constexpr size_t WS_CTL = 786432;
constexpr size_t WS_W = 1048576;
constexpr size_t SZ_FIN = (size_t)5632 * 1024 * 2, SZ_FOUT = (size_t)1024 * 2816 * 2;
constexpr size_t WS_FIN = WS_W;
constexpr size_t WS_FOUT = WS_FIN + 4 * SZ_FIN;
constexpr size_t WS_ABIN = WS_FOUT + 4 * SZ_FOUT;
constexpr size_t WS_ABOUT = WS_ABIN + (size_t)2816 * 1024 * 2;
constexpr size_t WS_NAQKV = WS_ABOUT + (size_t)1024 * 1024 * 2;
constexpr size_t WS_NAOUT = WS_NAQKV + (size_t)3072 * 1024 * 2;
constexpr size_t WS_RA = WS_NAOUT + (size_t)1024 * 1024 * 2;
constexpr size_t SZ_H = (size_t)T * 1024 * 2;
constexpr size_t WS_H = WS_RA, WS_Y = WS_RA + SZ_H;
constexpr size_t WS_RB = WS_RA + 2 * SZ_H;
constexpr size_t WS_END = WS_RB + (size_t)T * 3072 * 2;
constexpr size_t RA_RKT = 0, RA_RVT = 41943040, RA_GKC = 83886080, RA_GKS = 85983232, RA_GVTC = 94896128, RA_GVTS = 96993280,
                 RA_KVS = 105906176, RA_FB = 139460608;
constexpr size_t RA_NVT = 0, RA_NKC = 83886080, RA_NVTC = 88080384;

DI unsigned pk2(float lo, float hi) { bf16x2_t v = __builtin_convertvector((f32x2){lo, hi}, bf16x2_t); return __builtin_bit_cast(unsigned, v); }
DI bf16_t f2bf(float f) { return (bf16_t)(pk2(f, 0.f) & 0xffffu); }
DI float bf2f(unsigned short b) { return __uint_as_float(((unsigned)b) << 16); }
DI float bflo(unsigned u) { return __uint_as_float(u << 16); }
DI float bfhi(unsigned u) { return __uint_as_float(u & 0xffff0000u); }
DI float wave_sum(float v) {
#pragma unroll
    for (int o = 32; o >= 1; o >>= 1) v += __shfl_xor(v, o);
    return v;
}
DI float fexp2(float x) { return __builtin_amdgcn_exp2f(x); }
DI float silu_f(float g) { return g * __builtin_amdgcn_rcpf(1.f + fexp2(-LOG2E * g)); }
#define LDS_WAIT() asm volatile("s_waitcnt lgkmcnt(0)" ::: "memory")
#define MFMA32(a, b, c) __builtin_amdgcn_mfma_f32_32x32x16_bf16((a), (b), (c), 0, 0, 0)
DI int otid() { int t = threadIdx.x; asm volatile("" : "+v"(t)); return t; }
DI int crow(int i, int h) { return (i & 3) + 8 * (i >> 2) + 4 * h; }


#define XB_TMO      128
#define XB_XCNT(j)  (256  + 64 * (j))
#define XB_XSUB(j)  (1280 + 64 * (j))
#define XB_XGEN(j)  (2304 + 64 * (j))
#define XB_TOP      3328
#define XB_TOPGEN   3392
#define XCD_BAR_WORDS 3456
#define XB_SPIN_CAP (1u << 22)
DI unsigned xb_ld(unsigned* p)              { return __hip_atomic_load(p, __ATOMIC_RELAXED, __HIP_MEMORY_SCOPE_AGENT); }
DI unsigned xb_add(unsigned* p, unsigned v) { return __hip_atomic_fetch_add(p, v, __ATOMIC_RELAXED, __HIP_MEMORY_SCOPE_AGENT); }
DI unsigned xb_xcc_id() { return (unsigned)__builtin_amdgcn_s_getreg((3 << 11) | 20) & 0xFu; }
#define XB_SPIN(cond, bar) do { unsigned _sp = 0; while (cond) { __builtin_amdgcn_s_sleep(1); \
    if ((++_sp & 255u) == 0u) { if (xb_ld(&(bar)[XB_TMO])) break; if (_sp > XB_SPIN_CAP) { atomicAdd(&(bar)[XB_TMO], 1u); break; } } } } while (0)
struct XcdBarrier { unsigned* bar; unsigned x; volatile LAS unsigned* st; };
DI XcdBarrier xcd_barrier_post(unsigned* bar, volatile LAS unsigned* st) {
    XcdBarrier b; b.bar = bar; b.x = xb_xcc_id(); b.st = st;
    if (threadIdx.x == 0) (void)xb_add(&bar[XB_XCNT(b.x)], 1u);
    return b;
}
DI void xcd_barrier_complete(unsigned* bar, unsigned x, unsigned& nloc, unsigned& nx) {
    const unsigned G = gridDim.x * gridDim.y * gridDim.z;
    unsigned sum, cnt, mine, sp = 0u;
    for (;;) {
        sum = 0u; cnt = 0u; mine = 0u;
#pragma unroll
        for (unsigned j = 0; j < 16; ++j) { const unsigned c = xb_ld(&bar[XB_XCNT(j)]); sum += c; cnt += (c > 0u) ? 1u : 0u; mine = (j == x) ? c : mine; }
        if (sum == G) break;
        __builtin_amdgcn_s_sleep(1);
        if ((++sp & 255u) == 0u) { if (xb_ld(&bar[XB_TMO])) break; if (sp > XB_SPIN_CAP) { atomicAdd(&bar[XB_TMO], 1u); break; } }
    }
    nloc = mine > 0u ? mine : 1u; nx = cnt > 0u ? cnt : 1u;
}
DI void xcd_barrier(const XcdBarrier& b) {
    asm volatile("s_waitcnt vmcnt(0)" ::: "memory");
    __syncthreads();
    if (threadIdx.x == 0) {
        unsigned* bar = b.bar;
        __builtin_amdgcn_s_waitcnt(0);
        unsigned nloc = b.st[0], nx = b.st[1];
        if (nloc == 0u) { xcd_barrier_complete(bar, b.x, nloc, nx); b.st[0] = nloc; b.st[1] = nx; }
        const unsigned old = xb_add(&bar[XB_XSUB(b.x)], 1u);
        const unsigned gen = old / nloc;
        if (old + 1u == (gen + 1u) * nloc) {
            __builtin_amdgcn_fence(__ATOMIC_RELEASE, "agent");
            asm volatile("s_waitcnt vmcnt(0)" ::: "memory");
            const unsigned og = xb_add(&bar[XB_TOP], 1u);
            const unsigned tg = og / nx;
            if (og + 1u == (tg + 1u) * nx) xb_add(&bar[XB_TOPGEN], 1u);
            else XB_SPIN(xb_ld(&bar[XB_TOPGEN]) == tg, bar);
            __builtin_amdgcn_fence(__ATOMIC_ACQUIRE, "agent");
            xb_add(&bar[XB_XGEN(b.x)], 1u);
            asm volatile("s_waitcnt vmcnt(0)" ::: "memory");
        } else {
            XB_SPIN(xb_ld(&bar[XB_XGEN(b.x)]) == gen, bar);
            __builtin_amdgcn_fence(__ATOMIC_ACQUIRE, "agent");
            asm volatile("s_waitcnt vmcnt(0)" ::: "memory");
        }
    }
    __syncthreads();
}

namespace g8 {
constexpr int BM = 256, BK = 64, HALF = 128, HTB = HALF * BK * 2, NXCD = 8, WGM = 4;
DI int lds_byte(int r, int c) { const int st = (r >> 4) * 2 + (c >> 5), rr = r & 15, cc = c & 31, ob = rr * 64 + cc * 2; return st * 1024 + (ob ^ (((ob >> 9) & 1) << 5)); }
DI void stage_rc(int b, int& R, int& C) { const int st = b / 1024, sb = b % 1024, swz = sb ^ (((sb >> 9) & 1) << 5); R = (st >> 1) * 16 + swz / 64; C = (st & 1) * 32 + (swz % 64) / 2; }
DI int perm32(int rho) { const int n = rho >> 4, i = rho & 15; return 8 * (i >> 2) + 4 * n + (i & 3); }
struct Unit { int pm, pn, kt0, nt, part; };
struct Gemm { const bf16_t* A; int lda; const bf16_t* Bt; int M, N, K; };
struct StaticOrder {
    int nM, nN, nwg, G, c, ntk;
    DI void init(int M, int N, int K, int G_, int c_) { nM = M / BM; nN = N / BM; nwg = nM * nN; G = G_; c = c_; ntk = K / BK; }
    DI bool next(int i, Unit& u) const {
        const long L = (long)i * G + c; if (L >= nwg) return false;
        int wgid = (int)L; { const int q = nwg / NXCD, r = nwg % NXCD, xcd = wgid % NXCD, off = wgid / NXCD; wgid = (xcd < r ? xcd * (q + 1) : r * (q + 1) + (xcd - r) * q) + off; }
        const int nig = WGM * nN, gid = wgid / nig, fm = gid * WGM, gsz = (nM - fm) < WGM ? (nM - fm) : WGM;
        u.pm = fm + ((wgid % nig) % gsz); u.pn = (wgid % nig) / gsz; u.kt0 = 0; u.nt = ntk; u.part = 0; return true;
    }
};
struct SplitOrder {
    int ntk, c;
    DI void init(int K, int c_) { ntk = K / BK; c = c_; }
    DI bool next(int i, Unit& u) const {
        const int xcd = c & 7, slot = c >> 3;
        if (i < 2) { const int L = i * 256 + xcd * 32 + slot; u.pm = L >> 2; u.pn = L & 3; u.kt0 = 0; u.nt = ntk; u.part = 0; return true; }
        if (i == 2) { const int L = 512 + xcd * 16 + (slot >> 1), hf = slot & 1; u.pm = L >> 2; u.pn = L & 3; u.kt0 = hf * (ntk >> 1); u.nt = ntk >> 1; u.part = hf; return true; }
        return false;
    }
};
struct EpiBf16 {
    bf16_t* O; int ldc; bf16_t* O2 = nullptr;
    DI void operator()(const f32x4 (&acc)[2][2][4][2], const Unit& u, int wr, int wc, int fr, int fq) const {
        const int row0 = u.pm * BM + wr * 64 + fr, col0 = u.pn * BM + wc * 32 + 8 * fq;
#pragma unroll
        for (int ai = 0; ai < 2; ++ai)
#pragma unroll
            for (int m = 0; m < 4; ++m) { bf16_t* rowp = (u.part ? O2 - (size_t)32768 * ldc : O) + (size_t)(row0 + ai * HALF + m * 16) * ldc + col0;
#pragma unroll
                for (int bj = 0; bj < 2; ++bj) { const f32x4 v0 = acc[ai][bj][m][0], v1 = acc[ai][bj][m][1];
                    u32x4 w; w.x = pk2(v0[0], v0[1]); w.y = pk2(v0[2], v0[3]); w.z = pk2(v1[0], v1[1]); w.w = pk2(v1[2], v1[3]);
                    *(u32x4*)(rowp + bj * HALF) = w; } }
    }
};
struct EpiSwiGLU {
    bf16_t* O;
    DI void operator()(const f32x4 (&acc)[2][2][4][2], const Unit& u, int wr, int wc, int fr, int fq) const {
        const int row0 = u.pm * BM + wr * 64 + fr, col0 = u.pn * HALF + wc * 32 + 8 * fq;
#pragma unroll
        for (int ai = 0; ai < 2; ++ai)
#pragma unroll
            for (int m = 0; m < 4; ++m) { bf16_t* rowp = O + (size_t)(row0 + ai * HALF + m * 16) * DFF + col0;
                float r[8];
#pragma unroll
                for (int n = 0; n < 2; ++n)
#pragma unroll
                    for (int j = 0; j < 4; ++j) { const float g = acc[ai][0][m][n][j], up = acc[ai][1][m][n][j]; r[4 * n + j] = silu_f(g) * up; }
                u32x4 w; w.x = pk2(r[0], r[1]); w.y = pk2(r[2], r[3]); w.z = pk2(r[4], r[5]); w.w = pk2(r[6], r[7]);
                *(u32x4*)rowp = w; }
    }
};

template <class Epi, class Order>
DI void gemm_phase(LAS unsigned char* lds, const Gemm g, const Order& S, const Epi& E) {
    const int tid = otid(), wid = __builtin_amdgcn_readfirstlane(tid >> 6), lane = tid & 63, wr = wid >> 2, wc = wid & 3, fr = lane & 15, fq = lane >> 4;
    const int K = g.K, lda = g.lda;
    unsigned voffA[2], voffB[2];
#pragma unroll
    for (int i = 0; i < 2; ++i) { int R, C; stage_rc(tid * 16 + i * 8192, R, C); const int Rb = (R & ~31) + perm32(R & 31);
        voffA[i] = (unsigned)(R * lda + C) * 2u; voffB[i] = (unsigned)(Rb * K + C) * 2u; }
    const size_t kstep = (size_t)(BK * 2);
    const size_t hstepA = (size_t)HALF * lda * 2, hstepB = (size_t)HALF * K * 2;
    const size_t tstepA = 2 * hstepA, tstepB = 2 * hstepB;
    const unsigned ldsw = (unsigned)wid * 1024u;
    const int aoff = lds_byte(wr * 64 + fr, fq * 8), boff = lds_byte(wc * 32 + fr, fq * 8);
#define G8_SA(b, h) (((b) * 2 + (h)) * HTB)
#define G8_SB(b, h) ((4 + (b) * 2 + (h)) * HTB)
#define G8_STAGE(bufoff, gbase, voff) do { _Pragma("unroll") for (int _i = 0; _i < 2; ++_i) \
        __builtin_amdgcn_global_load_lds((const unsigned*)((const char*)(gbase) + (voff)[_i]), (LAS unsigned*)(lds + (bufoff) + ldsw + _i * 8192), 16, 0, 0); } while (0)
#define G8_LDA(dst, b, h) do { _Pragma("unroll") for (int m = 0; m < 4; ++m) _Pragma("unroll") for (int k = 0; k < 2; ++k) dst[m][k] = *(const LAS bf16x8*)(lds + G8_SA(b, h) + aoff + m * 2048 + k * 1024); } while (0)
#define G8_LDB(dst, b, h) do { _Pragma("unroll") for (int n = 0; n < 2; ++n) _Pragma("unroll") for (int k = 0; k < 2; ++k) dst[n][k] = *(const LAS bf16x8*)(lds + G8_SB(b, h) + boff + n * 2048 + k * 1024); } while (0)
#define G8_MMA(ai, bj, At, Bt) do { __builtin_amdgcn_s_setprio(1); _Pragma("unroll") for (int m = 0; m < 4; ++m) _Pragma("unroll") for (int n = 0; n < 2; ++n) _Pragma("unroll") for (int k = 0; k < 2; ++k) \
        acc[ai][bj][m][n] = __builtin_amdgcn_mfma_f32_16x16x32_bf16(Bt[n][k], At[m][k], acc[ai][bj][m][n], 0, 0, 0); __builtin_amdgcn_s_setprio(0); } while (0)
#define G8_WAIT_V(n) asm volatile("s_waitcnt vmcnt(" #n ")" ::: "memory")
#define G8_WAIT_L(n) asm volatile("s_waitcnt lgkmcnt(" #n ")" ::: "memory")
#define G8_BAR __builtin_amdgcn_s_barrier()
#define G8_SCHED __builtin_amdgcn_sched_barrier(0)
    Unit cur, nxt; int ui = 0;
    if (!S.next(0, cur)) return;
    f32x4 acc[2][2][4][2];
#pragma unroll
    for (int a = 0; a < 2; ++a)
#pragma unroll
        for (int b = 0; b < 2; ++b)
#pragma unroll
            for (int m = 0; m < 4; ++m)
#pragma unroll
                for (int n = 0; n < 2; ++n) acc[a][b][m][n] = (f32x4){0.f, 0.f, 0.f, 0.f};
    bf16x8 At[4][2], B0[2][2], B1[2][2];
    const char* cA = (const char*)g.A + (size_t)cur.pm * tstepA + (size_t)cur.kt0 * kstep; const char* cB = (const char*)g.Bt + (size_t)cur.pn * tstepB + (size_t)cur.kt0 * kstep;
    G8_STAGE(G8_SB(0, 0), cB, voffB); G8_STAGE(G8_SB(0, 1), cB + hstepB, voffB); G8_STAGE(G8_SA(0, 0), cA, voffA); G8_STAGE(G8_SA(0, 1), cA + hstepA, voffA);
    if (wr == 1) G8_BAR;
    G8_WAIT_V(2); G8_BAR;
    G8_STAGE(G8_SB(1, 0), cB + kstep, voffB); G8_STAGE(G8_SA(1, 0), cA + kstep, voffA); G8_STAGE(G8_SB(1, 1), cB + hstepB + kstep, voffB);
    G8_WAIT_V(6); G8_BAR;
    for (;;) {
        const bool has_next = S.next(ui + 1, nxt);
        const char* nA = has_next ? (const char*)g.A + (size_t)nxt.pm * tstepA + (size_t)nxt.kt0 * kstep : cA; const char* nB = has_next ? (const char*)g.Bt + (size_t)nxt.pn * tstepB + (size_t)nxt.kt0 * kstep : cB;
        const int nt = cur.nt;
        for (int t = 0; t < nt; t += 2) {
            const bool last = (t == nt - 2);
            const char* a1 = cA + (size_t)(t + 1) * kstep;
            const char* a2 = last ? nA : cA + (size_t)(t + 2) * kstep; const char* b2 = last ? nB : cB + (size_t)(t + 2) * kstep;
            const char* a3 = a2 + kstep; const char* b3 = b2 + kstep;
            G8_LDB(B0, 0, 0); G8_LDB(B1, 0, 1); G8_SCHED; G8_LDA(At, 0, 0); G8_STAGE(G8_SA(1, 1), a1 + hstepA, voffA);
            G8_WAIT_V(8); G8_WAIT_L(0); G8_BAR; G8_MMA(0, 0, At, B0); G8_MMA(0, 1, At, B1); G8_BAR; G8_SCHED;
            G8_LDA(At, 0, 1); G8_STAGE(G8_SB(0, 0), b2, voffB); G8_STAGE(G8_SB(0, 1), b2 + hstepB, voffB); G8_STAGE(G8_SA(0, 0), a2, voffA);
            G8_WAIT_V(8); G8_WAIT_L(0); G8_BAR; G8_MMA(1, 0, At, B0); G8_MMA(1, 1, At, B1); G8_BAR; G8_SCHED;
            G8_LDB(B0, 1, 0); G8_LDB(B1, 1, 1); G8_SCHED; G8_LDA(At, 1, 0); G8_STAGE(G8_SA(0, 1), a2 + hstepA, voffA);
            G8_WAIT_V(8); G8_WAIT_L(0); G8_BAR; G8_MMA(0, 0, At, B0); G8_MMA(0, 1, At, B1); G8_BAR; G8_SCHED;
            G8_LDA(At, 1, 1); G8_STAGE(G8_SB(1, 0), b3, voffB); G8_STAGE(G8_SB(1, 1), b3 + hstepB, voffB); G8_STAGE(G8_SA(1, 0), a3, voffA);
            G8_WAIT_V(8); G8_WAIT_L(0); G8_BAR; G8_MMA(1, 0, At, B0); G8_MMA(1, 1, At, B1); G8_BAR; G8_SCHED;
        }
        if (wr == 0) G8_BAR;
        E(acc, cur, wr, wc, fr, fq);
        if (!has_next) break;
#pragma unroll
        for (int a = 0; a < 2; ++a)
#pragma unroll
            for (int b = 0; b < 2; ++b)
#pragma unroll
                for (int m = 0; m < 4; ++m)
#pragma unroll
                    for (int n = 0; n < 2; ++n) acc[a][b][m][n] = (f32x4){0.f, 0.f, 0.f, 0.f};
        cur = nxt; cA = nA; cB = nB; ++ui;
        if (wr == 1) G8_BAR;
    }
    G8_WAIT_V(0);
    G8_BAR;
}
}

DI void phase_mod(const float* c, const float* c_ctx, const float* mod_w, const float* mod_b, float* mod, LAS float* lds) {
    const int tid = otid(), lane = tid & 63, wave = tid >> 6;
    LAS float* sc = lds;
    LAS float* red = lds + 9 * 1024;
    for (int idx = tid; idx < 9 * 1024; idx += 512) { const int ci = idx >> 10, k = idx & 1023; const float v = (ci == 0) ? c_ctx[k] : c[(ci - 1) * 1024 + k]; sc[idx] = silu_f(v); }
    __syncthreads();
    for (int item = blockIdx.x; item < 2 * 144; item += gridDim.x) {
        const int l = item / 144, j = (item % 144) * 64 + lane;
        float a0 = 0, a1 = 0, a2 = 0, a3 = 0, a4 = 0, a5 = 0, a6 = 0, a7 = 0, a8 = 0;
        const float* wp = mod_w + ((size_t)l * 1024 + wave * 128) * 9216 + j;
        LAS const float* sp = sc + wave * 128;
#pragma unroll 32
        for (int k = 0; k < 128; ++k) { const float w = wp[(size_t)k * 9216];
            a0 += sp[k] * w; a1 += sp[1024 + k] * w; a2 += sp[2048 + k] * w; a3 += sp[3072 + k] * w; a4 += sp[4096 + k] * w;
            a5 += sp[5120 + k] * w; a6 += sp[6144 + k] * w; a7 += sp[7168 + k] * w; a8 += sp[8192 + k] * w; }
        LAS float* rp = red + wave * 576 + lane;
        rp[0] = a0; rp[64] = a1; rp[128] = a2; rp[192] = a3; rp[256] = a4; rp[320] = a5; rp[384] = a6; rp[448] = a7; rp[512] = a8;
        __syncthreads();
        for (int e = tid; e < 576; e += 512) { float s = 0.f;
#pragma unroll
            for (int w2 = 0; w2 < 8; ++w2) s += red[w2 * 576 + e];
            const int ci = e >> 6, jj = (item % 144) * 64 + (e & 63);
            mod[((size_t)l * 9 + ci) * 9216 + jj] = s + mod_b[(size_t)l * 9216 + jj]; }
        __syncthreads();
    }
}
struct WItem { const float* W; bf16_t* WT; int K, N, mode, item; float qs; };
DI void witem_load(const WItem& d, f32x4 (&v)[8], int lane) {
    const int nblk = d.N / 32, kb = d.item / nblk, nb = d.item % nblk, k0 = 64 * kb, n0 = 32 * nb;
    const int lr = lane >> 3, c4 = (lane & 7) * 4;
#pragma unroll
    for (int i = 0; i < 8; ++i) v[i] = __builtin_nontemporal_load((const f32x4*)(d.W + (size_t)(k0 + 8 * i + lr) * d.N + n0 + c4));
}
DI void witem_finish(const WItem& d, const f32x4 (&v)[8], LAS float* scr, int lane) {
    const int nblk = d.N / 32, kb = d.item / nblk, nb = d.item % nblk, k0 = 64 * kb, n0 = 32 * nb;
    const int lr = lane >> 3, c4 = (lane & 7) * 4;
    const float cs = (n0 < 1024) ? d.qs : 1.f;
#pragma unroll
    for (int i = 0; i < 8; ++i) { LAS float* s = scr + (8 * i + lr) * 33 + c4; s[0] = v[i].x * cs; s[1] = v[i].y * cs; s[2] = v[i].z * cs; s[3] = v[i].w * cs; }
    LDS_WAIT();
    int d0 = n0;
    if (d.mode == 1) { const int bj = n0 / DFF, rem = n0 % DFF; d0 = 256 * (rem / 128) + 128 * bj + (rem % 128); }
    const int c = lane & 7;
#pragma unroll
    for (int j = 0; j < 4; ++j) { const int n = (lane >> 3) + 8 * j; LAS const float* s = scr + (8 * c) * 33 + n;
        u32x4 o; o.x = pk2(s[0 * 33], s[1 * 33]); o.y = pk2(s[2 * 33], s[3 * 33]); o.z = pk2(s[4 * 33], s[5 * 33]); o.w = pk2(s[6 * 33], s[7 * 33]);
        *(u32x4*)(d.WT + (size_t)(d0 + n) * d.K + k0 + 8 * c) = o; }
    LDS_WAIT();
}
struct Params { const float* in[26]; float* out; unsigned char* ws; };

DI WItem witem_of(const Params& p, int it) {
    constexpr int I_FIN = 16 * 176, I_FOUT = 44 * 32, I_ABIN = 16 * 88, I_ABOUT = 16 * 32, I_NAQKV = 16 * 96;
    WItem d; d.qs = 1.f; d.mode = 0;
    int r = it;
    if (r < 4 * I_FIN) { const int mi = r / I_FIN; d.W = p.in[14] + (size_t)mi * 1024 * 5632; d.K = 1024; d.N = 5632; d.WT = (bf16_t*)(p.ws + WS_FIN + mi * SZ_FIN); d.mode = 1; d.item = r % I_FIN; return d; } r -= 4 * I_FIN;
    if (r < 4 * I_FOUT) { const int mi = r / I_FOUT; d.W = p.in[15] + (size_t)mi * 2816 * 1024; d.K = 2816; d.N = 1024; d.WT = (bf16_t*)(p.ws + WS_FOUT + mi * SZ_FOUT); d.item = r % I_FOUT; return d; } r -= 4 * I_FOUT;
    if (r < I_ABIN) { d.W = p.in[16]; d.K = 1024; d.N = 2816; d.WT = (bf16_t*)(p.ws + WS_ABIN); d.item = r; return d; } r -= I_ABIN;
    if (r < I_ABOUT) { d.W = p.in[17]; d.K = 1024; d.N = 1024; d.WT = (bf16_t*)(p.ws + WS_ABOUT); d.item = r; return d; } r -= I_ABOUT;
    if (r < I_NAQKV) { d.W = p.in[23]; d.K = 1024; d.N = 3072; d.WT = (bf16_t*)(p.ws + WS_NAQKV); d.item = r; d.qs = 0.125f * LOG2E; return d; } r -= I_NAQKV;
    d.W = p.in[24]; d.K = 1024; d.N = 1024; d.WT = (bf16_t*)(p.ws + WS_NAOUT); d.item = r; return d;
}
DI void phase_weights(const Params& p, LAS unsigned char* lds) {
    const int tid = otid(), lane = tid & 63, wave = tid >> 6;
    LAS float* scr = (LAS float*)(lds + 57344 + wave * 8704);
    const int gw = blockIdx.x * 8 + wave, NGW = gridDim.x * 8;
    constexpr int NITEMS = 4 * (16 * 176) + 4 * (44 * 32) + 16 * 88 + 16 * 32 + 16 * 96 + 16 * 32;
    for (int it = gw; it < NITEMS; it += 2 * NGW) {
        const int it2 = it + NGW; const bool has2 = it2 < NITEMS;
        const WItem dA = witem_of(p, it); const WItem dB = witem_of(p, has2 ? it2 : it);
        f32x4 vA[8], vB[8];
        witem_load(dA, vA, lane);
        if (has2) witem_load(dB, vB, lane);
        witem_finish(dA, vA, scr, lane);
        if (has2) witem_finish(dB, vB, scr, lane);
    }
}

template <bool HAS_Y, bool HAS_H, bool DUMMY = false, bool STORE_X = true>
DI void row_phase(const float* x0, const float* x1, float* X, const bf16_t* Y, const bf16_t* Y2, bf16_t* H,
                  const float* modg, int sg, float wgt, const float* gpost, const float* modn, int sn, const float* gpre) {
    const int tid = otid(), lane = tid & 63, gw = blockIdx.x * 8 + (tid >> 6), NGW = gridDim.x * 8;
    if (NGW == 2048 && !DUMMY) {
        for (int tA = gw; tA < T; tA += 4096) {
            const int tB = tA + 2048;
            const int ci = tA < TC ? 0 : 1 + ((tA - TC) >> 12);
            const float* xa = (tA < TC) ? x0 + (size_t)tA * 1024 : x1 + (size_t)(tA - TC) * 1024;
            const float* xb = (tB < TC) ? x0 + (size_t)tB * 1024 : x1 + (size_t)(tB - TC) * 1024;
            f32x4 vA[4], vB[4], cg[4], ca[4], cs[4];
            u32x2 yA[4], yB[4], zA[4], zB[4];
#pragma unroll
            for (int j = 0; j < 4; ++j) { vA[j] = *(const f32x4*)(xa + 4 * lane + 256 * j); vB[j] = *(const f32x4*)(xb + 4 * lane + 256 * j); }
            if (HAS_Y) {
#pragma unroll
                for (int j = 0; j < 4; ++j) { yA[j] = *(const u32x2*)(Y + (size_t)tA * 1024 + 4 * lane + 256 * j); yB[j] = *(const u32x2*)(Y + (size_t)tB * 1024 + 4 * lane + 256 * j);
                    zA[j] = (tA >= 32768) ? *(const u32x2*)(Y2 + (size_t)(tA - 32768) * 1024 + 4 * lane + 256 * j) : (u32x2){0u, 0u};
                    zB[j] = (tB >= 32768) ? *(const u32x2*)(Y2 + (size_t)(tB - 32768) * 1024 + 4 * lane + 256 * j) : (u32x2){0u, 0u}; }
                const float* gate = modg + (size_t)ci * 9216 + sg * 1024;
#pragma unroll
                for (int j = 0; j < 4; ++j) cg[j] = *(const f32x4*)(gate + 4 * lane + 256 * j) * *(const f32x4*)(gpost + 4 * lane + 256 * j);
            }
            if (HAS_H) {
                const float* shift = modn + (size_t)ci * 9216 + sn * 1024; const float* scale = shift + 1024;
#pragma unroll
                for (int j = 0; j < 4; ++j) { cs[j] = *(const f32x4*)(shift + 4 * lane + 256 * j); ca[j] = *(const f32x4*)(gpre + 4 * lane + 256 * j) * (*(const f32x4*)(scale + 4 * lane + 256 * j) + 1.f); }
            }
            if (HAS_Y) {
                f32x4 ya[4], yb[4]; float sa = 0.f, sb = 0.f;
#pragma unroll
                for (int j = 0; j < 4; ++j) {
                    ya[j] = (f32x4){bflo(yA[j].x) + bflo(zA[j].x), bfhi(yA[j].x) + bfhi(zA[j].x), bflo(yA[j].y) + bflo(zA[j].y), bfhi(yA[j].y) + bfhi(zA[j].y)};
                    yb[j] = (f32x4){bflo(yB[j].x) + bflo(zB[j].x), bfhi(yB[j].x) + bfhi(zB[j].x), bflo(yB[j].y) + bflo(zB[j].y), bfhi(yB[j].y) + bfhi(zB[j].y)};
                    sa += (ya[j].x * ya[j].x + ya[j].y * ya[j].y) + (ya[j].z * ya[j].z + ya[j].w * ya[j].w);
                    sb += (yb[j].x * yb[j].x + yb[j].y * yb[j].y) + (yb[j].z * yb[j].z + yb[j].w * yb[j].w); }
#pragma unroll
                for (int o = 32; o >= 1; o >>= 1) { sa += __shfl_xor(sa, o); sb += __shfl_xor(sb, o); }
                const float ra = rsqrtf(sa * (1.f / 1024.f) + 1e-6f) * wgt, rb = rsqrtf(sb * (1.f / 1024.f) + 1e-6f) * wgt;
#pragma unroll
                for (int j = 0; j < 4; ++j) { vA[j] = vA[j] + cg[j] * (ya[j] * ra); vB[j] = vB[j] + cg[j] * (yb[j] * rb); }
            }
            if (STORE_X) {
#pragma unroll
                for (int j = 0; j < 4; ++j) { *(f32x4*)(X + (size_t)tA * 1024 + 4 * lane + 256 * j) = vA[j]; *(f32x4*)(X + (size_t)tB * 1024 + 4 * lane + 256 * j) = vB[j]; }
            }
            if (HAS_H) {
                float sa = 0.f, sb = 0.f;
#pragma unroll
                for (int j = 0; j < 4; ++j) { sa += (vA[j].x * vA[j].x + vA[j].y * vA[j].y) + (vA[j].z * vA[j].z + vA[j].w * vA[j].w);
                    sb += (vB[j].x * vB[j].x + vB[j].y * vB[j].y) + (vB[j].z * vB[j].z + vB[j].w * vB[j].w); }
#pragma unroll
                for (int o = 32; o >= 1; o >>= 1) { sa += __shfl_xor(sa, o); sb += __shfl_xor(sb, o); }
                const float ra = rsqrtf(sa * (1.f / 1024.f) + 1e-6f), rb = rsqrtf(sb * (1.f / 1024.f) + 1e-6f);
#pragma unroll
                for (int j = 0; j < 4; ++j) {
                    const f32x4 ha = (vA[j] * ra) * ca[j] + cs[j], hb = (vB[j] * rb) * ca[j] + cs[j];
                    u32x2 oa, ob; oa.x = pk2(ha.x, ha.y); oa.y = pk2(ha.z, ha.w); ob.x = pk2(hb.x, hb.y); ob.y = pk2(hb.z, hb.w);
                    *(u32x2*)(H + (size_t)tA * 1024 + 4 * lane + 256 * j) = oa; *(u32x2*)(H + (size_t)tB * 1024 + 4 * lane + 256 * j) = ob; }
            }
        }
        return;
    }
    for (int tA = gw; tA < T; tA += 2 * NGW) {
        const int tB = tA + NGW; const bool hasB = tB < T;
        f32x4 vA[4], vB[4]; u32x2 yA[4], yB[4], zA[4], zB[4];
#define ROW_LOAD(t, v, yr, zr) do { const float* xr = ((t) < TC) ? x0 + (size_t)(t) * 1024 : x1 + (size_t)((t) - TC) * 1024; \
        _Pragma("unroll") for (int j = 0; j < 4; ++j) v[j] = *(const f32x4*)(xr + 4 * lane + 256 * j); \
        if (HAS_Y) { _Pragma("unroll") for (int j = 0; j < 4; ++j) { yr[j] = *(const u32x2*)(Y + (size_t)(t) * 1024 + 4 * lane + 256 * j); \
            zr[j] = ((t) >= 32768) ? *(const u32x2*)(Y2 + (size_t)((t) - 32768) * 1024 + 4 * lane + 256 * j) : (u32x2){0u, 0u}; } } } while (0)
        ROW_LOAD(tA, vA, yA, zA);
        if (hasB) ROW_LOAD(tB, vB, yB, zB);
#undef ROW_LOAD
#define ROW_COMPUTE(t, v, yr, zr) do { \
        const int ci = (t) < TC ? 0 : 1 + (((t) - TC) >> 12); \
        if (HAS_Y) { f32x4 y[4]; float ss = 0.f; \
            _Pragma("unroll") for (int j = 0; j < 4; ++j) { \
                y[j] = (f32x4){bflo(yr[j].x) + bflo(zr[j].x), bfhi(yr[j].x) + bfhi(zr[j].x), bflo(yr[j].y) + bflo(zr[j].y), bfhi(yr[j].y) + bfhi(zr[j].y)}; \
                ss += (y[j].x * y[j].x + y[j].y * y[j].y) + (y[j].z * y[j].z + y[j].w * y[j].w); } \
            ss = wave_sum(ss); \
            const float r = rsqrtf(ss * (1.f / 1024.f) + 1e-6f) * wgt; \
            const float* gate = modg + (size_t)ci * 9216 + sg * 1024; \
            _Pragma("unroll") for (int j = 0; j < 4; ++j) { const f32x4 g = *(const f32x4*)(gate + 4 * lane + 256 * j); const f32x4 gp = *(const f32x4*)(gpost + 4 * lane + 256 * j); \
                v[j] = v[j] + (g * gp) * (y[j] * r); } } \
        if (STORE_X) { float* xo = X + (size_t)(DUMMY ? ((t) & 63) : (t)) * 1024; \
            _Pragma("unroll") for (int j = 0; j < 4; ++j) *(f32x4*)(xo + 4 * lane + 256 * j) = v[j]; } \
        if (HAS_H) { float ss = 0.f; \
            _Pragma("unroll") for (int j = 0; j < 4; ++j) ss += (v[j].x * v[j].x + v[j].y * v[j].y) + (v[j].z * v[j].z + v[j].w * v[j].w); \
            ss = wave_sum(ss); \
            const float r = rsqrtf(ss * (1.f / 1024.f) + 1e-6f); \
            const float* shift = modn + (size_t)ci * 9216 + sn * 1024; const float* scale = shift + 1024; \
            bf16_t* ho = H + (size_t)(DUMMY ? ((t) & 63) : (t)) * 1024; \
            _Pragma("unroll") for (int j = 0; j < 4; ++j) { const f32x4 sh = *(const f32x4*)(shift + 4 * lane + 256 * j), scl = *(const f32x4*)(scale + 4 * lane + 256 * j), gp = *(const f32x4*)(gpre + 4 * lane + 256 * j); \
                const f32x4 hv = (v[j] * r) * gp * (scl + 1.f) + sh; \
                u32x2 o; o.x = pk2(hv.x, hv.y); o.y = pk2(hv.z, hv.w); \
                *(u32x2*)(ho + 4 * lane + 256 * j) = o; } } } while (0)
        ROW_COMPUTE(tA, vA, yA, zA);
        if (hasB) ROW_COMPUTE(tB, vB, yB, zB);
#undef ROW_COMPUTE
    }
}

template <class SrcF>
DI void wave_transpose64(LAS unsigned short* scr, SrcF src, bf16_t* dst, size_t ldd, int lane) {
    const int lr = lane >> 3, ch = lane & 7;
    u32x4 v[8];
#pragma unroll
    for (int i = 0; i < 8; ++i) v[i] = src(8 * i + lr, ch);
#pragma unroll
    for (int i = 0; i < 8; ++i) { LAS unsigned* s = (LAS unsigned*)(scr + (8 * i + lr) * 66 + 8 * ch); s[0] = v[i].x; s[1] = v[i].y; s[2] = v[i].z; s[3] = v[i].w; }
    LDS_WAIT();
#pragma unroll
    for (int j = 0; j < 8; ++j) { const int d = lr + 8 * j; LAS const unsigned short* s = scr + (8 * ch) * 66 + d;
        u32x4 o;
        o.x = (unsigned)s[0 * 66] | ((unsigned)s[1 * 66] << 16); o.y = (unsigned)s[2 * 66] | ((unsigned)s[3 * 66] << 16);
        o.z = (unsigned)s[4 * 66] | ((unsigned)s[5 * 66] << 16); o.w = (unsigned)s[6 * 66] | ((unsigned)s[7 * 66] << 16);
        *(u32x4*)(dst + (size_t)d * ldd + 8 * ch) = o; }
    LDS_WAIT();
}
struct TItem { const void* src; size_t lds_; int f32; bf16_t* dst; size_t ldd; };
DI void titem_load(const TItem& d, u32x4 (&v)[8], int lane) {
    const int lr = lane >> 3, ch = lane & 7;
    if (d.f32) {
#pragma unroll
        for (int i = 0; i < 8; ++i) { const float* p = (const float*)d.src + (size_t)(8 * i + lr) * d.lds_ + 8 * ch; const f32x4 a = *(const f32x4*)p, b = *(const f32x4*)(p + 4);
            v[i].x = pk2(a.x, a.y); v[i].y = pk2(a.z, a.w); v[i].z = pk2(b.x, b.y); v[i].w = pk2(b.z, b.w); }
    } else {
#pragma unroll
        for (int i = 0; i < 8; ++i) v[i] = *(const u32x4*)((const bf16_t*)d.src + (size_t)(8 * i + lr) * d.lds_ + 8 * ch);
    }
}
DI void titem_finish(const TItem& d, const u32x4 (&v)[8], LAS unsigned short* scr, int lane) {
    const int lr = lane >> 3, ch = lane & 7;
#pragma unroll
    for (int i = 0; i < 8; ++i) { LAS unsigned* s = (LAS unsigned*)(scr + (8 * i + lr) * 66 + 8 * ch); s[0] = v[i].x; s[1] = v[i].y; s[2] = v[i].z; s[3] = v[i].w; }
    LDS_WAIT();
#pragma unroll
    for (int j = 0; j < 8; ++j) { const int dd = lr + 8 * j; LAS const unsigned short* s = scr + (8 * ch) * 66 + dd;
        u32x4 o;
        o.x = (unsigned)s[0 * 66] | ((unsigned)s[1 * 66] << 16); o.y = (unsigned)s[2 * 66] | ((unsigned)s[3 * 66] << 16);
        o.z = (unsigned)s[4 * 66] | ((unsigned)s[5 * 66] << 16); o.w = (unsigned)s[6 * 66] | ((unsigned)s[7 * 66] << 16);
        *(u32x4*)(d.dst + (size_t)dd * d.ldd + 8 * ch) = o; }
    LDS_WAIT();
}
DI u32x4 ld8_bf16(const bf16_t* p) { return *(const u32x4*)p; }
DI u32x4 ld8_f32(const float* p) { const f32x4 a = *(const f32x4*)p, b = *(const f32x4*)(p + 4); u32x4 o; o.x = pk2(a.x, a.y); o.y = pk2(a.z, a.w); o.z = pk2(b.x, b.y); o.w = pk2(b.z, b.w); return o; }

DI void phase_prep0(const Params& p, LAS unsigned char* lds) {
    const int tid = otid(), lane = tid & 63, wave = tid >> 6;
    const int gw = blockIdx.x * 8 + wave, NGW = gridDim.x * 8;
    bf16_t* P = (bf16_t*)(p.ws + WS_RB);
    unsigned char* RA = p.ws + WS_RA;
    bf16_t* rKt = (bf16_t*)(RA + RA_RKT); bf16_t* rVt = (bf16_t*)(RA + RA_RVT);
    bf16_t* gKc = (bf16_t*)(RA + RA_GKC); bf16_t* gKs = (bf16_t*)(RA + RA_GKS);
    bf16_t* gVtc = (bf16_t*)(RA + RA_GVTC); bf16_t* gVts = (bf16_t*)(RA + RA_GVTS);
    LAS float* rt = (LAS float*)lds;
    for (int e = tid; e < 1024; e += 512) { const int pos = e >> 4, i = e & 15; const float inv = powf(10000.f, -(float)i / 16.f); const float ang = (float)pos * inv;
        rt[e] = cosf(ang); rt[1024 + e] = sinf(ang); }
    __syncthreads();
    LAS unsigned short* scr = (LAS unsigned short*)(lds + 16384 + wave * 8704);
    constexpr int NA_ = 640 * 8, NB_ = 640 * 8, NC_ = 128 * 2, ND_ = 512 * 2, NE_ = 64, NTOT_ = NA_ + NB_ + NC_ + ND_ + NE_;
    auto item_of = [&](int it) {
        TItem d; d.f32 = 0; d.lds_ = 2816;
        int r = it;
        if (r < NA_ + NB_) { const int isv = r >= NA_; if (isv) r -= NA_; const int tb = r >> 3, h = r & 7, t0 = 64 * tb;
            d.src = P + (size_t)t0 * 2816 + (isv ? 1024 : 512) + 64 * h; d.dst = (isv ? rVt : rKt) + (size_t)(64 * h) * T + t0; d.ldd = (size_t)T; return d; }
        r -= NA_ + NB_;
        if (r < NC_) { const int tb = r >> 1, kvh = r & 1, t0 = 64 * tb, b = t0 >> 8;
            d.src = P + (size_t)t0 * 2816 + 2688 + 64 * kvh; d.dst = gVtc + (size_t)(b * 128 + 64 * kvh) * 256 + (t0 & 255); d.ldd = 256; return d; }
        r -= NC_;
        if (r < ND_) { const int tb = r >> 1, kvh = r & 1, n0g = 64 * tb, b = n0g >> 12, n0 = n0g & 4095;
            d.src = P + (size_t)(TC + n0g) * 2816 + 2688 + 64 * kvh; d.dst = gVts + (size_t)(b * 128 + 64 * kvh) * 4352 + n0; d.ldd = 4352; return d; }
        r -= ND_;
        { const int b = r >> 3, pb = (r >> 1) & 3, kvh = r & 1;
            d.src = p.in[3] + ((size_t)(b * 256 + 64 * pb) * 2 + kvh) * 64; d.lds_ = 128; d.f32 = 1; d.dst = gVts + (size_t)(b * 128 + 64 * kvh) * 4352 + 4096 + 64 * pb; d.ldd = 4352; return d; }
    };
    for (int it = gw; it < NTOT_; it += 2 * NGW) {
        const int it2 = it + NGW; const bool has2 = it2 < NTOT_;
        const TItem dA = item_of(it); const TItem dB = item_of(has2 ? it2 : it);
        u32x4 vA[8], vB[8];
        titem_load(dA, vA, lane);
        if (has2) titem_load(dB, vB, lane);
        titem_finish(dA, vA, scr, lane);
        if (has2) titem_finish(dB, vB, scr, lane);
    }
    for (int e8 = blockIdx.x * 512 + tid; e8 < 8 * 256 * 128 / 8; e8 += gridDim.x * 512) { const int e = e8 * 8, b = e >> 15, rem = e & 32767;
        *(u32x4*)(gKs + (size_t)(b * 4352 + 4096) * 128 + rem) = ld8_f32(p.in[2] + e); }
    const float* qn = p.in[21]; const float* kn = p.in[22];
    const int sub = lane & 7;
    float qnw[8], knw[8];
#pragma unroll
    for (int j = 0; j < 8; ++j) { qnw[j] = qn[8 * sub + j] * (0.125f * LOG2E); knw[j] = kn[8 * sub + j]; }
    u32x4 nq = (u32x4){0u, 0u, 0u, 0u}, nk = nq, nv = nq;
#define PREP_LOADRAW(t_) do { const bf16_t* pr_ = P + (size_t)(t_) * 2816; nq = *(const u32x4*)(pr_ + 2048 + 8 * lane); nk = *(const u32x4*)(pr_ + 2560 + 8 * (lane & 15)); nv = *(const u32x4*)(pr_ + 2688 + 8 * (lane & 15)); } while (0)
    if (gw < T) PREP_LOADRAW(gw);
    for (int t = gw; t < T; t += NGW) {
        bf16_t* pr = P + (size_t)t * 2816;
        const u32x4 rawq = nq, rawk = nk, rawv = nv;
        if (t + NGW < T) PREP_LOADRAW(t + NGW);
        const bool smp = t >= TC; const int n = (t - TC) & 4095, bb = (t - TC) >> 12;
        const int pos = (sub < 4) ? (n >> 6) : (n & 63);
        float cs[8], sn[8];
#pragma unroll
        for (int j = 0; j < 8; ++j) { const int i = 8 * (sub & 1) + j; cs[j] = rt[pos * 16 + i]; sn[j] = rt[1024 + pos * 16 + i]; }
        const bool isx2 = (sub >> 1) & 1;
        { const u32x4 raw = rawq;
          float v[8] = {bflo(raw.x), bfhi(raw.x), bflo(raw.y), bfhi(raw.y), bflo(raw.z), bfhi(raw.z), bflo(raw.w), bfhi(raw.w)};
          float ss = 0.f;
#pragma unroll
          for (int j = 0; j < 8; ++j) ss += v[j] * v[j];
          ss += __shfl_xor(ss, 1); ss += __shfl_xor(ss, 2); ss += __shfl_xor(ss, 4);
          const float rs = rsqrtf(ss * (1.f / 64.f) + 1e-6f);
#pragma unroll
          for (int j = 0; j < 8; ++j) v[j] = v[j] * rs * qnw[j];
          if (smp) {
#pragma unroll
              for (int j = 0; j < 8; ++j) { const float pv = __shfl_xor(v[j], 2); v[j] = isx2 ? (v[j] * cs[j] + pv * sn[j]) : (v[j] * cs[j] - pv * sn[j]); }
          }
          u32x4 o; o.x = pk2(v[0], v[1]); o.y = pk2(v[2], v[3]); o.z = pk2(v[4], v[5]); o.w = pk2(v[6], v[7]);
          *(u32x4*)(pr + 2048 + 8 * lane) = o; }
        { const u32x4 raw = rawk;
          float v[8] = {bflo(raw.x), bfhi(raw.x), bflo(raw.y), bfhi(raw.y), bflo(raw.z), bfhi(raw.z), bflo(raw.w), bfhi(raw.w)};
          float ss = 0.f;
#pragma unroll
          for (int j = 0; j < 8; ++j) ss += v[j] * v[j];
          ss += __shfl_xor(ss, 1); ss += __shfl_xor(ss, 2); ss += __shfl_xor(ss, 4);
          const float rs = rsqrtf(ss * (1.f / 64.f) + 1e-6f);
#pragma unroll
          for (int j = 0; j < 8; ++j) v[j] = v[j] * rs * knw[j];
          if (!smp) {
              if (lane < 16) {
                  float* ok = p.out + O_GK + (size_t)t * 128 + 8 * lane;
                  *(f32x4*)ok = (f32x4){v[0], v[1], v[2], v[3]}; *(f32x4*)(ok + 4) = (f32x4){v[4], v[5], v[6], v[7]};
                  u32x4 o; o.x = pk2(v[0], v[1]); o.y = pk2(v[2], v[3]); o.z = pk2(v[4], v[5]); o.w = pk2(v[6], v[7]);
                  *(u32x4*)(gKc + (size_t)t * 128 + 8 * lane) = o;
                  const u32x4 rv = rawv;
                  float* ov = p.out + O_GV + (size_t)t * 128 + 8 * lane;
                  *(f32x4*)ov = (f32x4){bflo(rv.x), bfhi(rv.x), bflo(rv.y), bfhi(rv.y)}; *(f32x4*)(ov + 4) = (f32x4){bflo(rv.z), bfhi(rv.z), bflo(rv.w), bfhi(rv.w)};
              }
          } else {
#pragma unroll
              for (int j = 0; j < 8; ++j) { const float pv = __shfl_xor(v[j], 2); v[j] = isx2 ? (v[j] * cs[j] + pv * sn[j]) : (v[j] * cs[j] - pv * sn[j]); }
              if (lane < 16) { u32x4 o; o.x = pk2(v[0], v[1]); o.y = pk2(v[2], v[3]); o.z = pk2(v[4], v[5]); o.w = pk2(v[6], v[7]);
                  *(u32x4*)(gKs + (size_t)(bb * 4352 + n) * 128 + 8 * lane) = o; }
          } }
    }
}

#undef PREP_LOADRAW
DI void phase_prep1(const Params& p, LAS unsigned char* lds) {
    const int tid = otid(), lane = tid & 63, wave = tid >> 6;
    const int gw = blockIdx.x * 8 + wave, NGW = gridDim.x * 8;
    const bf16_t* P = (const bf16_t*)(p.ws + WS_RB);
    unsigned char* RA = p.ws + WS_RA;
    bf16_t* nVt = (bf16_t*)(RA + RA_NVT); bf16_t* nKc = (bf16_t*)(RA + RA_NKC); bf16_t* nVtc = (bf16_t*)(RA + RA_NVTC);
    LAS unsigned short* scr = (LAS unsigned short*)(lds + wave * 8704);
    constexpr int NA_ = 640 * 16, NB_ = 8 * 4 * 16, NTOT_ = NA_ + NB_;
    auto item_of = [&](int it) {
        TItem d; d.f32 = 0; d.lds_ = 3072;
        int r = it;
        if (r < NA_) { const int tb = r >> 4, hd = r & 15, t0 = 64 * tb;
            d.src = P + (size_t)t0 * 3072 + 2048 + 64 * hd; d.dst = nVt + (size_t)(64 * hd) * T + t0; d.ldd = (size_t)T; return d; }
        r -= NA_;
        { const int b = r >> 6, pb = (r >> 4) & 3, hd = r & 15;
            d.src = p.in[7] + ((size_t)(b * 256 + 64 * pb) * 16 + hd) * 64; d.lds_ = 1024; d.f32 = 1; d.dst = nVtc + (size_t)(b * 1024 + 64 * hd) * 256 + 64 * pb; d.ldd = 256; return d; }
    };
    for (int it = gw; it < NTOT_; it += 2 * NGW) {
        const int it2 = it + NGW; const bool has2 = it2 < NTOT_;
        const TItem dA = item_of(it); const TItem dB = item_of(has2 ? it2 : it);
        u32x4 vA[8], vB[8];
        titem_load(dA, vA, lane);
        if (has2) titem_load(dB, vB, lane);
        titem_finish(dA, vA, scr, lane);
        if (has2) titem_finish(dB, vB, scr, lane);
    }
    for (int e8 = blockIdx.x * 512 + tid; e8 < 8 * 256 * 1024 / 8; e8 += gridDim.x * 512) *(u32x4*)(nKc + (size_t)e8 * 8) = ld8_f32(p.in[6] + (size_t)e8 * 8);
#pragma unroll 4
    for (int e = blockIdx.x * 512 + tid; e < TC * 256; e += gridDim.x * 512) { const int t = e >> 8, c8 = (e & 255) * 8;
        const u32x4 rv = *(const u32x4*)(P + (size_t)t * 3072 + 1024 + c8);
        float* o = (c8 < 1024) ? p.out + O_NK + (size_t)t * 1024 + c8 : p.out + O_NV + (size_t)t * 1024 + (c8 - 1024);
        *(f32x4*)o = (f32x4){bflo(rv.x), bfhi(rv.x), bflo(rv.y), bfhi(rv.y)}; *(f32x4*)(o + 4) = (f32x4){bflo(rv.z), bfhi(rv.z), bflo(rv.w), bfhi(rv.w)}; }
}

DI float log2_sigmoid(float x) { return -log1pf(expf(-x)) * LOG2E; }

DI void phase_r1(const Params& p) {
    const int tid = otid(), lane = tid & 63, wave = tid >> 6, r = lane & 31, hh = lane >> 5;
    const int gw = blockIdx.x * 8 + wave, NGW = gridDim.x * 8;
    unsigned char* RA = p.ws + WS_RA;
    const bf16_t* rKt = (const bf16_t*)(RA + RA_RKT); const bf16_t* rVt = (const bf16_t*)(RA + RA_RVT);
    float* KVs = (float*)(RA + RA_KVS);
    for (int it = gw; it < 160 * 8 * 2; it += NGW) {
        const int dir = it & 1, cidx = it >> 4, h = (it >> 1) & 7, t0 = 256 * cidx;
        const bool ctx = cidx < 32;
        const float l2 = log2_sigmoid(p.in[dir ? 19 : 18][h]);
        const float wa = dir ? 0.f : 255.f, ws = dir ? 1.f : -1.f;
        f32x16 acc[2][2];
#pragma unroll
        for (int a = 0; a < 2; ++a)
#pragma unroll
            for (int b = 0; b < 2; ++b)
#pragma unroll
                for (int i = 0; i < 16; ++i) acc[a][b][i] = 0.f;
        const bf16_t* vb = rVt + (size_t)(64 * h + r) * T + t0 + 8 * hh;
        const bf16_t* kb = rKt + (size_t)(64 * h + r) * T + t0 + 8 * hh;
#pragma unroll 2
        for (int ks = 0; ks < 16; ++ks) {
            const int j0 = 16 * ks + 8 * hh;
            bf16x8 aV[2], bK[2];
            float wj[8];
#pragma unroll
            for (int jj = 0; jj < 8; ++jj) wj[jj] = 0.125f * fexp2((wa + ws * (float)(j0 + jj)) * l2);
#pragma unroll
            for (int blk = 0; blk < 2; ++blk) {
                aV[blk] = *(const bf16x8*)(vb + (size_t)(32 * blk) * T + 16 * ks);
                const u32x4 kr = *(const u32x4*)(kb + (size_t)(32 * blk) * T + 16 * ks);
                u32x4 ow;
                ow.x = pk2(bflo(kr.x) * wj[0], bfhi(kr.x) * wj[1]); ow.y = pk2(bflo(kr.y) * wj[2], bfhi(kr.y) * wj[3]);
                ow.z = pk2(bflo(kr.z) * wj[4], bfhi(kr.z) * wj[5]); ow.w = pk2(bflo(kr.w) * wj[6], bfhi(kr.w) * wj[7]);
                bK[blk] = __builtin_bit_cast(bf16x8, ow);
            }
#pragma unroll
            for (int a = 0; a < 2; ++a)
#pragma unroll
                for (int b = 0; b < 2; ++b) {
                    const bf16x8 Af = ctx ? bK[a] : aV[a], Bf = ctx ? aV[b] : bK[b];
                    acc[a][b] = MFMA32(Af, Bf, acc[a][b]);
                }
        }
        float* od;
        if (ctx) od = p.out + (dir ? O_RB : O_RF) + (size_t)(cidx * 8 + h) * 4096;
        else { const int bc = cidx - 32, b = bc >> 4, c = bc & 15; od = KVs + ((size_t)((b * 8 + h) * 16 + c) * 2 + dir) * 4096; }
#pragma unroll
        for (int a = 0; a < 2; ++a)
#pragma unroll
            for (int b = 0; b < 2; ++b)
#pragma unroll
                for (int i = 0; i < 16; ++i) od[(32 * a + crow(i, hh)) * 64 + 32 * b + r] = acc[a][b][i];
    }
}
DI void phase_r2(const Params& p) {
    unsigned char* RA = p.ws + WS_RA;
    const float* KVs = (const float*)(RA + RA_KVS); bf16_t* FB = (bf16_t*)(RA + RA_FB);
    const int tid2 = otid();
    for (int e = blockIdx.x * 512 + tid2; e < 64 * 2 * 4096; e += gridDim.x * 512) {
        const int bh = e >> 13, dir = (e >> 12) & 1, el = e & 4095, dv = el >> 6, dk = el & 63, h = bh & 7;
        const float l2 = log2_sigmoid(p.in[dir ? 19 : 18][h]);
        const float gC = fexp2(256.f * l2);
        float S = p.in[dir ? 5 : 4][(size_t)bh * 4096 + dk * 64 + dv];
        if (dir == 0) { for (int c = 0; c < 16; ++c) { const size_t o = ((size_t)(bh * 16 + c) * 2) * 4096 + el; FB[o] = f2bf(S); S = gC * S + KVs[o]; } }
        else { for (int c = 15; c >= 0; --c) { const size_t o = ((size_t)(bh * 16 + c) * 2 + 1) * 4096 + el; FB[o] = f2bf(S); S = gC * S + KVs[o]; } }
    }
}

enum { MODE_SOFTMAX = 0, MODE_NA = 1, MODE_RET = 2 };
struct AttnUnit {
    const bf16_t* q; int ldq; bf16_t* o; int ldo;
    const bf16_t* k0; int ldk0; const bf16_t* vt0; int ldvt0; int nt0;
    const bf16_t* k1; int ldk1; const bf16_t* vt1; int ldvt1; int nt;
    float sc;
    int r_unit0, rlo;
    float l2f, l2b; const bf16_t* FB; const float* gn;
};
template <int MODE>
DI void attn_unit(LAS unsigned char* lds, const AttnUnit& U, LAS const float* rpbs) {
    const int tid = otid(), lane = tid & 63, w = __builtin_amdgcn_readfirstlane(tid >> 6), qi = lane & 31, hh = lane >> 5;
    const bf16_t* qrow = U.q + (size_t)(32 * w + qi) * U.ldq + 8 * hh;
    bf16x8 bq[4];
#pragma unroll
    for (int ks = 0; ks < 4; ++ks) bq[ks] = *(const bf16x8*)(qrow + 16 * ks);
    f32x16 o0, o1;
#pragma unroll
    for (int i = 0; i < 16; ++i) { o0[i] = 0.f; o1[i] = 0.f; }
    float m_run = -INFINITY, l_run = 0.f;
    const int sr = tid >> 3, scol = (tid & 7) * 8;
    const unsigned stoff = (unsigned)(sr * 72 + scol) * 2u;
    const unsigned vstoffA = (unsigned)(sr * 72 + 16 * ((tid & 7) >> 1) + 4 * (tid & 1)) * 2u;
    u32x4 kreg, vreg;
    const int nr = U.r_unit0 + (w >> 1), ncq = 32 * (w & 1) + qi;
    const int nr0 = min(max(nr - 4, 0), 56), nc0 = min(max(ncq - 8, 0), 48);
    const int iq = 32 * w + qi;
#define ATT_LOAD(t) do { const bf16_t *kp, *vp; if ((t) < U.nt0) { kp = U.k0 + (size_t)(64 * (t) + sr) * U.ldk0 + scol; vp = U.vt0 + (size_t)sr * U.ldvt0 + 64 * (t) + scol; } \
        else { const int t1 = (t) - U.nt0; kp = U.k1 + (size_t)(64 * t1 + sr) * U.ldk1 + scol; vp = U.vt1 + (size_t)sr * U.ldvt1 + 64 * t1 + scol; } \
        kreg = *(const u32x4*)kp; vreg = *(const u32x4*)vp; } while (0)
#define ATT_WRITE(b) do { *(LAS u32x4*)(lds + (b) * 18432 + stoff) = kreg; \
        *(LAS u32x2*)(lds + (b) * 18432 + 9216 + vstoffA) = (u32x2){vreg.x, vreg.y}; *(LAS u32x2*)(lds + (b) * 18432 + 9216 + vstoffA + 16) = (u32x2){vreg.z, vreg.w}; } while (0)
    __syncthreads();
    ATT_LOAD(0); ATT_WRITE(0);
    __syncthreads();
    for (int t = 0; t < U.nt; ++t) {
        const int cur = t & 1;
        if (t + 1 < U.nt) ATT_LOAD(t + 1);
        bool active = true; int dr = 0; bool win = false;
        if (MODE == MODE_NA) { win = t < U.nt0; if (win) { const int kr = U.rlo + t; active = (kr >= nr0) && (kr < nr0 + 8); dr = kr - nr + 7; } }
        if (active) {
            LAS const unsigned char* Kb = lds + cur * 18432; LAS const unsigned char* Vb = Kb + 9216;
            f32x16 s0, s1;
#pragma unroll
            for (int i = 0; i < 16; ++i) { s0[i] = 0.f; s1[i] = 0.f; }
#pragma unroll
            for (int ks = 0; ks < 4; ++ks) {
                const bf16x8 a0 = *(LAS const bf16x8*)(Kb + (qi * 72 + 16 * ks + 8 * hh) * 2);
                const bf16x8 a1 = *(LAS const bf16x8*)(Kb + ((32 + qi) * 72 + 16 * ks + 8 * hh) * 2);
                s0 = MFMA32(a0, bq[ks], s0); s1 = MFMA32(a1, bq[ks], s1);
            }
            if (MODE == MODE_RET) {
#pragma unroll
                for (int i = 0; i < 16; ++i) {
                    const int j0 = 64 * t + crow(i, hh), j1 = j0 + 32;
                    const int d0 = iq - j0, d1 = iq - j1;
                    const float w0 = 0.125f * fexp2(d0 >= 0 ? (float)d0 * U.l2f : (float)(-d0) * U.l2b);
                    const float w1 = 0.125f * fexp2(d1 >= 0 ? (float)d1 * U.l2f : (float)(-d1) * U.l2b);
                    s0[i] *= w0; s1[i] *= w1;
                }
            } else {
                if (MODE == MODE_NA && win) {
                    LAS const float* bp = rpbs + dr * 31 + 15 - ncq;
#pragma unroll
                    for (int i = 0; i < 16; ++i) {
                        const int kc0 = crow(i, hh), kc1 = kc0 + 32;
                        const bool v0 = (unsigned)(kc0 - nc0) < 16u, v1 = (unsigned)(kc1 - nc0) < 16u;
                        const float b0 = v0 ? bp[kc0] : 0.f, b1 = v1 ? bp[kc1] : 0.f;
                        s0[i] = v0 ? s0[i] + b0 : -INFINITY; s1[i] = v1 ? s1[i] + b1 : -INFINITY;
                    }
                }
                float mx = fmaxf(s0[0], s1[0]);
#pragma unroll
                for (int i = 1; i < 16; ++i) mx = fmaxf(fmaxf(mx, s0[i]), s1[i]);
                { const unsigned mu = __float_as_uint(mx); auto r2 = __builtin_amdgcn_permlane32_swap(mu, mu, false, false); mx = fmaxf(__uint_as_float(r2[0]), __uint_as_float(r2[1])); }
                const bool upd = mx > m_run + 8.f;
                if (__builtin_amdgcn_ballot_w64(upd) != 0ull) {
                    const float mn = upd ? mx : m_run;
                    const float alpha = fexp2(m_run - mn);
                    m_run = mn; l_run *= alpha;
#pragma unroll
                    for (int i = 0; i < 16; ++i) { o0[i] *= alpha; o1[i] *= alpha; }
                }
                const f32x2 mm = (f32x2){m_run, m_run};
                f32x2 ps2 = (f32x2){0.f, 0.f};
#pragma unroll
                for (int i = 0; i < 8; ++i) {
                    const f32x2 t0 = (f32x2){s0[2 * i], s0[2 * i + 1]} - mm, t1 = (f32x2){s1[2 * i], s1[2 * i + 1]} - mm;
                    s0[2 * i] = fexp2(t0.x); s0[2 * i + 1] = fexp2(t0.y); s1[2 * i] = fexp2(t1.x); s1[2 * i + 1] = fexp2(t1.y);
                    ps2 += (f32x2){s0[2 * i], s0[2 * i + 1]}; ps2 += (f32x2){s1[2 * i], s1[2 * i + 1]};
                }
                l_run += ps2.x + ps2.y;
            }
#pragma unroll
            for (int kb = 0; kb < 2; ++kb)
#pragma unroll
                for (int s = 0; s < 2; ++s) {
                    u32x4 pw;
                    if (kb == 0) { pw.x = pk2(s0[8 * s], s0[8 * s + 1]); pw.y = pk2(s0[8 * s + 2], s0[8 * s + 3]); pw.z = pk2(s0[8 * s + 4], s0[8 * s + 5]); pw.w = pk2(s0[8 * s + 6], s0[8 * s + 7]); }
                    else { pw.x = pk2(s1[8 * s], s1[8 * s + 1]); pw.y = pk2(s1[8 * s + 2], s1[8 * s + 3]); pw.z = pk2(s1[8 * s + 4], s1[8 * s + 5]); pw.w = pk2(s1[8 * s + 6], s1[8 * s + 7]); }
                    const bf16x8 pb = __builtin_bit_cast(bf16x8, pw);
                    const int koff = (32 * kb + 16 * s + 8 * hh) * 2;
                    const bf16x8 aV0 = *(LAS const bf16x8*)(Vb + (qi * 72) * 2 + koff);
                    const bf16x8 aV1 = *(LAS const bf16x8*)(Vb + ((32 + qi) * 72) * 2 + koff);
                    o0 = MFMA32(aV0, pb, o0); o1 = MFMA32(aV1, pb, o1);
                }
        }
        if (t + 1 < U.nt) ATT_WRITE(cur ^ 1);
        __syncthreads();
    }
#undef ATT_LOAD
#undef ATT_WRITE
    bf16_t* orow = U.o + (size_t)(32 * w + qi) * U.ldo;
    if (MODE == MODE_RET) {
        if (U.FB) {
            f32x16 c0, c1, e0, e1;
#pragma unroll
            for (int i = 0; i < 16; ++i) { c0[i] = 0.f; c1[i] = 0.f; e0[i] = 0.f; e1[i] = 0.f; }
            const bf16_t* Fp = U.FB + (size_t)qi * 64 + 8 * hh; const bf16_t* Bp = Fp + 4096;
#pragma unroll
            for (int ks = 0; ks < 4; ++ks) {
                const bf16x8 f0 = *(const bf16x8*)(Fp + 16 * ks), f1 = *(const bf16x8*)(Fp + 2048 + 16 * ks);
                const bf16x8 g0 = *(const bf16x8*)(Bp + 16 * ks), g1 = *(const bf16x8*)(Bp + 2048 + 16 * ks);
                c0 = MFMA32(f0, bq[ks], c0); c1 = MFMA32(f1, bq[ks], c1); e0 = MFMA32(g0, bq[ks], e0); e1 = MFMA32(g1, bq[ks], e1);
            }
            const float wf = fexp2((float)(iq + 1) * U.l2f), wb = fexp2((float)(256 - iq) * U.l2b);
#pragma unroll
            for (int i = 0; i < 16; ++i) { o0[i] += wf * c0[i] + wb * e0[i]; o1[i] += wf * c1[i] + wb * e1[i]; }
        }
        float s = 0.f;
#pragma unroll
        for (int i = 0; i < 16; ++i) s += o0[i] + o1[i];
        s += __shfl_xor(s, 32);
        const float mu = s * (1.f / 64.f);
        float vs = 0.f;
#pragma unroll
        for (int i = 0; i < 16; ++i) { const float a = o0[i] - mu, b = o1[i] - mu; vs += a * a + b * b; }
        vs += __shfl_xor(vs, 32);
        const float rstd = rsqrtf(vs * (1.f / 64.f) + 1e-5f);
#pragma unroll
        for (int db = 0; db < 2; ++db)
#pragma unroll
            for (int g = 0; g < 4; ++g) { const int d = 32 * db + 8 * g + 4 * hh;
                const u32x2 graw = *(const u32x2*)(orow + d);
                const f32x4 gw = *(const f32x4*)(U.gn + d);
                const float g0 = silu_f(bflo(graw.x)), g1 = silu_f(bfhi(graw.x)), g2 = silu_f(bflo(graw.y)), g3 = silu_f(bfhi(graw.y));
                const float x0 = (db ? o1[4 * g] : o0[4 * g]), x1 = (db ? o1[4 * g + 1] : o0[4 * g + 1]), x2 = (db ? o1[4 * g + 2] : o0[4 * g + 2]), x3 = (db ? o1[4 * g + 3] : o0[4 * g + 3]);
                u32x2 ov; ov.x = pk2((x0 - mu) * rstd * gw.x * g0, (x1 - mu) * rstd * gw.y * g1); ov.y = pk2((x2 - mu) * rstd * gw.z * g2, (x3 - mu) * rstd * gw.w * g3);
                *(u32x2*)(orow + d) = ov; }
    } else {
        float l; { const unsigned lu = __float_as_uint(l_run); auto r2 = __builtin_amdgcn_permlane32_swap(lu, lu, false, false); l = __uint_as_float(r2[0]) + __uint_as_float(r2[1]); }
        const float inv = 1.f / l;
#pragma unroll
        for (int db = 0; db < 2; ++db)
#pragma unroll
            for (int g = 0; g < 4; ++g) { const int d = 32 * db + 8 * g + 4 * hh;
                const float x0 = (db ? o1[4 * g] : o0[4 * g]), x1 = (db ? o1[4 * g + 1] : o0[4 * g + 1]), x2 = (db ? o1[4 * g + 2] : o0[4 * g + 2]), x3 = (db ? o1[4 * g + 3] : o0[4 * g + 3]);
                u32x2 ov; ov.x = pk2(x0 * inv, x1 * inv); ov.y = pk2(x2 * inv, x3 * inv);
                *(u32x2*)(orow + d) = ov; }
    }
}

DI void phase_att0(const Params& p, LAS unsigned char* lds, bool dummy = false) {
    bf16_t* P = (bf16_t*)(p.ws + WS_RB);
    unsigned char* RA = p.ws + WS_RA;
    const bf16_t* rVt = (const bf16_t*)(RA + RA_RVT);
    const bf16_t* gKc = (const bf16_t*)(RA + RA_GKC); const bf16_t* gKs = (const bf16_t*)(RA + RA_GKS);
    const bf16_t* gVtc = (const bf16_t*)(RA + RA_GVTC); const bf16_t* gVts = (const bf16_t*)(RA + RA_GVTS);
    const bf16_t* FB = (const bf16_t*)(RA + RA_FB);
    for (int u = blockIdx.x; u < 2560; u += gridDim.x) {
        AttnUnit U;
        U.k1 = nullptr; U.vt1 = nullptr; U.ldk1 = 0; U.ldvt1 = 0; U.r_unit0 = 0; U.rlo = 0; U.l2f = 0.f; U.l2b = 0.f; U.FB = nullptr; U.gn = nullptr;
        U.sc = 0.125f * LOG2E;
        if (u < 1024) {
            int b, kvh, rem2;
            if (gridDim.x == 256) { const int x = blockIdx.x & 7, slot = blockIdx.x >> 3, k = u >> 8, set = x + 8 * (k >> 1); b = set >> 1; kvh = set & 1; rem2 = (k & 1) * 32 + slot; }
            else { b = u >> 7; const int rem = u & 127; kvh = rem >> 6; rem2 = rem & 63; }
            const int qh = 4 * kvh + (rem2 >> 4), qb = rem2 & 15;
            U.q = P + (size_t)(TC + b * 4096 + qb * 256) * 2816 + 2048 + 64 * qh; U.ldq = 2816; U.o = (bf16_t*)U.q; U.ldo = 2816;
            U.k0 = gKs + (size_t)b * 4352 * 128 + 64 * kvh; U.ldk0 = 128; U.vt0 = gVts + (size_t)(b * 128 + 64 * kvh) * 4352; U.ldvt0 = 4352; U.nt0 = 68; U.nt = 68;
            if (dummy) { U.o = (bf16_t*)(p.ws + WS_END); U.ldo = 64; }
            attn_unit<MODE_SOFTMAX>(lds, U, nullptr);
        } else if (u < 1280) {
            const int v = u - 1024, b = v >> 3, qh = v & 7, kvh = qh >> 2;
            U.q = P + (size_t)(b * 256) * 2816 + 2048 + 64 * qh; U.ldq = 2816; U.o = (bf16_t*)U.q; U.ldo = 2816;
            U.k0 = gKc + (size_t)b * 256 * 128 + 64 * kvh; U.ldk0 = 128; U.vt0 = gVtc + (size_t)(b * 128 + 64 * kvh) * 256; U.ldvt0 = 256; U.nt0 = 4; U.nt = 4;
            if (dummy) { U.o = (bf16_t*)(p.ws + WS_END); U.ldo = 64; }
            attn_unit<MODE_SOFTMAX>(lds, U, nullptr);
        } else {
            const int v = u - 1280, cidx = v >> 3, h = v & 7, t0 = 256 * cidx;
            U.q = P + (size_t)t0 * 2816 + 64 * h; U.ldq = 2816; U.o = P + (size_t)t0 * 2816 + 1536 + 64 * h; U.ldo = 2816;
            U.k0 = P + (size_t)t0 * 2816 + 512 + 64 * h; U.ldk0 = 2816; U.vt0 = rVt + (size_t)(64 * h) * T + t0; U.ldvt0 = T; U.nt0 = 4; U.nt = 4;
            U.l2f = log2_sigmoid(p.in[18][h]); U.l2b = log2_sigmoid(p.in[19][h]); U.gn = p.in[20] + 64 * h;
            if (cidx >= 32) { const int bc = cidx - 32, b = bc >> 4, c = bc & 15; U.FB = FB + ((size_t)((b * 8 + h) * 16 + c) * 2) * 4096; }
            if (dummy) { U.o = (bf16_t*)(p.ws + WS_END); U.ldo = 64; }
            attn_unit<MODE_RET>(lds, U, nullptr);
        }
    }
}
DI void phase_att1(const Params& p, LAS unsigned char* lds, bool dummy = false) {
    bf16_t* P = (bf16_t*)(p.ws + WS_RB);
    unsigned char* RA = p.ws + WS_RA;
    const bf16_t* nVt = (const bf16_t*)(RA + RA_NVT); const bf16_t* nKc = (const bf16_t*)(RA + RA_NKC); const bf16_t* nVtc = (const bf16_t*)(RA + RA_NVTC);
    LAS float* rpbs = (LAS float*)(lds + 40960);
    for (int u = blockIdx.x; u < 2560; u += gridDim.x) {
        AttnUnit U;
        U.l2f = 0.f; U.l2b = 0.f; U.FB = nullptr; U.gn = nullptr; U.sc = 0.125f * LOG2E;
        if (u < 2048) {
            int b, hd, rg;
            if (gridDim.x == 256) { const int x = blockIdx.x & 7, slot = blockIdx.x >> 3, j = (u >> 8) * 32 + slot, pair = 16 * x + (j >> 4); b = pair >> 4; hd = pair & 15; rg = j & 15; }
            else { b = u >> 8; hd = (u >> 4) & 15; rg = u & 15; }
            const int rlo = min(max(4 * rg - 4, 0), 56), rhi0 = min(max(4 * rg - 1, 0), 56), nwin = rhi0 + 8 - rlo;
            const int tb = TC + b * 4096;
            __syncthreads();
            for (int e = otid(); e < 465; e += 512) rpbs[e] = p.in[25][(size_t)hd * 465 + e] * LOG2E;
            U.q = P + (size_t)(tb + 256 * rg) * 3072 + 64 * hd; U.ldq = 3072; U.o = (bf16_t*)U.q; U.ldo = 3072;
            U.k0 = P + (size_t)(tb + 64 * rlo) * 3072 + 1024 + 64 * hd; U.ldk0 = 3072; U.vt0 = nVt + (size_t)(64 * hd) * T + tb + 64 * rlo; U.ldvt0 = T; U.nt0 = nwin;
            U.k1 = nKc + (size_t)(b * 256) * 1024 + 64 * hd; U.ldk1 = 1024; U.vt1 = nVtc + (size_t)(b * 1024 + 64 * hd) * 256; U.ldvt1 = 256; U.nt = nwin + 4;
            U.r_unit0 = 4 * rg; U.rlo = rlo;
            if (dummy) { U.o = (bf16_t*)(p.ws + WS_END); U.ldo = 64; }
            attn_unit<MODE_NA>(lds, U, rpbs);
        } else {
            const int v = u - 2048, b = v >> 4, hd = v & 15;
            U.k1 = nullptr; U.vt1 = nullptr; U.ldk1 = 0; U.ldvt1 = 0; U.r_unit0 = 0; U.rlo = 0;
            U.q = P + (size_t)(b * 256) * 3072 + 64 * hd; U.ldq = 3072; U.o = (bf16_t*)U.q; U.ldo = 3072;
            U.k0 = P + (size_t)(b * 256) * 3072 + 1024 + 64 * hd; U.ldk0 = 3072; U.vt0 = nVt + (size_t)(64 * hd) * T + b * 256; U.ldvt0 = T; U.nt0 = 4; U.nt = 4;
            if (dummy) { U.o = (bf16_t*)(p.ws + WS_END); U.ldo = 64; }
            attn_unit<MODE_SOFTMAX>(lds, U, nullptr);
        }
    }
}

__global__ void __launch_bounds__(512, 2) fwd_megakernel(Params p) {
    extern __shared__ __attribute__((aligned(16))) unsigned char lds_raw[];
    LAS unsigned char* lds = (LAS unsigned char*)lds_raw;
    cg::grid_group grid = cg::this_grid();
    const int G = gridDim.x;
    float* X = p.out;
    float* mod = (float*)(p.ws + WS_MOD);
    bf16_t* H = (bf16_t*)(p.ws + WS_H); bf16_t* Y = (bf16_t*)(p.ws + WS_Y); bf16_t* PB = (bf16_t*)(p.ws + WS_RB); bf16_t* Y2 = (bf16_t*)(p.ws + WS_END);
    const float* npre = p.in[12]; const float* npost = p.in[13];
    unsigned* barw = (unsigned*)(p.ws + WS_CTL);
    if (blockIdx.x == 0) for (int e = threadIdx.x; e < XCD_BAR_WORDS; e += 512) barw[e] = 0u;
    if (threadIdx.x < 4) ((LAS unsigned*)(lds + 131072))[threadIdx.x] = 0u;
    __syncthreads();
    XcdBarrier xbar; xbar.bar = barw; xbar.x = 0; xbar.st = (volatile LAS unsigned*)(lds + 131072);
#define SYNC() xcd_barrier(xbar)
#define GEMM(Aptr, lda_, Bptr, N_, K_, EPI) do { g8::Gemm g{Aptr, lda_, Bptr, T, N_, K_}; g8::StaticOrder S; S.init(T, N_, K_, G, (int)blockIdx.x); g8::gemm_phase(lds, g, S, EPI); } while (0)
#define GEMM_Y(Aptr, lda_, Bptr, K_) do { g8::Gemm g{Aptr, lda_, Bptr, T, 1024, K_}; g8::SplitOrder S; S.init(K_, (int)blockIdx.x); g8::gemm_phase(lds, g, S, (g8::EpiBf16{Y, 1024, Y2})); } while (0)

    phase_mod(p.in[8], p.in[9], p.in[10], p.in[11], mod, (LAS float*)lds);
    phase_weights(p, lds);
    grid.sync();
    xbar = xcd_barrier_post(barw, (volatile LAS unsigned*)(lds + 131072));
    for (int l = 0; l < 2; ++l) {
        const float* modl = mod + (size_t)l * 9 * 9216;
        if (l == 0) row_phase<false, true, false, false>(p.in[0], p.in[1], X, nullptr, nullptr, H, nullptr, 0, 0.f, nullptr, modl, 0, npre + (l * 3 + 0) * 1024);
        else row_phase<true, true>(X, X + (size_t)TC * 1024, X, Y, Y2, H, mod, 8, 0.5f, npost + (0 * 3 + 2) * 1024, modl, 0, npre + (l * 3 + 0) * 1024);
        SYNC();
        GEMM(H, 1024, (const bf16_t*)(p.ws + WS_FIN + (size_t)(l * 2 + 0) * SZ_FIN), 5632, 1024, (g8::EpiSwiGLU{PB}));
        SYNC();
        GEMM_Y(PB, DFF, (const bf16_t*)(p.ws + WS_FOUT + (size_t)(l * 2 + 0) * SZ_FOUT), DFF);
        SYNC();
        if (PROBE & 4) { row_phase<true, true, true>(X, X + (size_t)TC * 1024, (float*)(p.ws + WS_END + 33554432), Y, Y2, (bf16_t*)(p.ws + WS_END + 33554432 + 262144), modl, 2, 0.5f, npost + (l * 3 + 0) * 1024, modl, 3, npre + (l * 3 + 1) * 1024); SYNC(); }
        row_phase<true, true>(l == 0 ? p.in[0] : X, l == 0 ? p.in[1] : X + (size_t)TC * 1024, X, Y, Y2, H, modl, 2, 0.5f, npost + (l * 3 + 0) * 1024, modl, 3, npre + (l * 3 + 1) * 1024);
        SYNC();
        if (l == 0) {
            GEMM(H, 1024, (const bf16_t*)(p.ws + WS_ABIN), 2816, 1024, (g8::EpiBf16{PB, 2816}));
            SYNC();
            phase_prep0(p, lds);
            SYNC();
            phase_r1(p);
            SYNC();
            phase_r2(p);
            SYNC();
            if (PROBE & 2) { phase_att0(p, lds, true); SYNC(); }
            phase_att0(p, lds);
            SYNC();
            GEMM_Y(PB + 1536, 2816, (const bf16_t*)(p.ws + WS_ABOUT), 1024);
        } else {
            GEMM(H, 1024, (const bf16_t*)(p.ws + WS_NAQKV), 3072, 1024, (g8::EpiBf16{PB, 3072}));
            SYNC();
            phase_prep1(p, lds);
            SYNC();
            if (PROBE & 2) { phase_att1(p, lds, true); SYNC(); }
            phase_att1(p, lds);
            SYNC();
            GEMM_Y(PB, 3072, (const bf16_t*)(p.ws + WS_NAOUT), 1024);
        }
        SYNC();
        if (PROBE & 4) { row_phase<true, true, true>(X, X + (size_t)TC * 1024, (float*)(p.ws + WS_END + 33554432), Y, Y2, (bf16_t*)(p.ws + WS_END + 33554432 + 262144), modl, 5, 1.0f, npost + (l * 3 + 1) * 1024, modl, 6, npre + (l * 3 + 2) * 1024); SYNC(); }
        row_phase<true, true>(X, X + (size_t)TC * 1024, X, Y, Y2, H, modl, 5, 1.0f, npost + (l * 3 + 1) * 1024, modl, 6, npre + (l * 3 + 2) * 1024);
        SYNC();
        GEMM(H, 1024, (const bf16_t*)(p.ws + WS_FIN + (size_t)(l * 2 + 1) * SZ_FIN), 5632, 1024, (g8::EpiSwiGLU{PB}));
        SYNC();
        GEMM_Y(PB, DFF, (const bf16_t*)(p.ws + WS_FOUT + (size_t)(l * 2 + 1) * SZ_FOUT), DFF);
        SYNC();
    }
    row_phase<true, false>(X, X + (size_t)TC * 1024, X, Y, Y2, nullptr, mod + (size_t)9 * 9216, 8, 0.5f, npost + (1 * 3 + 2) * 1024, nullptr, 0, nullptr);
}

extern "C" void kernel_launch(void* const* d_in, const int* in_sizes, int n_in, void* d_out, int out_size, void* d_ws, size_t ws_size, hipStream_t stream) {
    static int grid = 0;
    if (grid == 0) {
        int dev = 0, cus = 0, per_cu = 0;
        hipGetDevice(&dev);
        hipDeviceGetAttribute(&cus, hipDeviceAttributeMultiprocessorCount, dev);
        if (hipFuncSetAttribute((const void*)fwd_megakernel, hipFuncAttributeMaxDynamicSharedMemorySize, LDS_BYTES) != hipSuccess) fprintf(stderr, "kernel_launch: hipFuncSetAttribute failed\n");
        hipOccupancyMaxActiveBlocksPerMultiprocessor(&per_cu, (const void*)fwd_megakernel, 512, LDS_BYTES);
        (void)hipGetLastError();
        if (per_cu < 1) { fprintf(stderr, "kernel_launch: occupancy query says %d blocks/CU\n", per_cu); per_cu = 1; }
        grid = cus;
        if (ws_size < WS_END) fprintf(stderr, "kernel_launch: workspace too small: %zu < %zu\n", ws_size, (size_t)WS_END);
        if (n_in != 26) fprintf(stderr, "kernel_launch: expected 26 inputs, got %d\n", n_in);
    }
    Params p{};
    for (int i = 0; i < 26; ++i) p.in[i] = (const float*)d_in[i];
    p.out = (float*)d_out; p.ws = (unsigned char*)d_ws;
    void* args[] = {&p};
    hipError_t e = hipLaunchCooperativeKernel((const void*)fwd_megakernel, dim3(grid), dim3(512), args, LDS_BYTES, stream);
    if (e != hipSuccess) fprintf(stderr, "cooperative launch failed: %s (grid %d)\n", hipGetErrorString(e), grid);
}
```

```cpp
#include <hip/hip_runtime.h>
#include <hip/hip_cooperative_groups.h>
#include <cstdio>
#include <cstdint>
namespace cg = cooperative_groups;

#define LAS __attribute__((address_space(3)))
#define DI __device__ __forceinline__
typedef unsigned short bf16_t;
typedef short bf16x8 __attribute__((ext_vector_type(8)));
typedef float f32x4 __attribute__((ext_vector_type(4)));
typedef float f32x2 __attribute__((ext_vector_type(2)));
typedef float f32x16 __attribute__((ext_vector_type(16)));
typedef unsigned u32x4 __attribute__((ext_vector_type(4)));
typedef unsigned u32x2 __attribute__((ext_vector_type(2)));
typedef __bf16 bf16x2_t __attribute__((ext_vector_type(2)));

#ifndef PROBE
#define PROBE 0
#endif
constexpr int T = 40960, TC = 8192, D = 1024, DFF = 2816;
constexpr int LDS_BYTES = 131072 + 16;
constexpr float LOG2E = 1.4426950408889634f;
constexpr size_t O_GK = 41943040, O_GV = 42991616, O_RF = 44040192, O_RB = 45088768, O_NK = 46137344, O_NV = 54525952;
constexpr size_t WS_MOD = 0;
constexpr size_t WS_CTL = 786432;
constexpr size_t WS_W = 1048576;
constexpr size_t SZ_FIN = (size_t)5632 * 1024 * 2, SZ_FOUT = (size_t)1024 * 2816 * 2;
constexpr size_t WS_FIN = WS_W;
constexpr size_t WS_FOUT = WS_FIN + 4 * SZ_FIN;
constexpr size_t WS_ABIN = WS_FOUT + 4 * SZ_FOUT;
constexpr size_t WS_ABOUT = WS_ABIN + (size_t)2816 * 1024 * 2;
constexpr size_t WS_NAQKV = WS_ABOUT + (size_t)1024 * 1024 * 2;
constexpr size_t WS_NAOUT = WS_NAQKV + (size_t)3072 * 1024 * 2;
constexpr size_t WS_RA = WS_NAOUT + (size_t)1024 * 1024 * 2;
constexpr size_t SZ_H = (size_t)T * 1024 * 2;
constexpr size_t WS_H = WS_RA, WS_Y = WS_RA + SZ_H;
constexpr size_t WS_RB = WS_RA + 2 * SZ_H;
constexpr size_t WS_END = WS_RB + (size_t)T * 3072 * 2;
constexpr size_t RA_RKT = 0, RA_RVT = 41943040, RA_GKC = 83886080, RA_GKS = 85983232, RA_GVTC = 94896128, RA_GVTS = 96993280,
                 RA_KVS = 105906176, RA_FB = 139460608;
constexpr size_t RA_NVT = 0, RA_NKC = 83886080, RA_NVTC = 88080384;

DI unsigned pk2(float lo, float hi) { bf16x2_t v = __builtin_convertvector((f32x2){lo, hi}, bf16x2_t); return __builtin_bit_cast(unsigned, v); }
DI bf16_t f2bf(float f) { return (bf16_t)(pk2(f, 0.f) & 0xffffu); }
DI float bf2f(unsigned short b) { return __uint_as_float(((unsigned)b) << 16); }
DI float bflo(unsigned u) { return __uint_as_float(u << 16); }
DI float bfhi(unsigned u) { return __uint_as_float(u & 0xffff0000u); }
DI float wave_sum(float v) {
#pragma unroll
    for (int o = 32; o >= 1; o >>= 1) v += __shfl_xor(v, o);
    return v;
}
DI float fexp2(float x) { return __builtin_amdgcn_exp2f(x); }
DI float silu_f(float g) { return g * __builtin_amdgcn_rcpf(1.f + fexp2(-LOG2E * g)); }
#define LDS_WAIT() asm volatile("s_waitcnt lgkmcnt(0)" ::: "memory")
#define MFMA32(a, b, c) __builtin_amdgcn_mfma_f32_32x32x16_bf16((a), (b), (c), 0, 0, 0)
DI int otid() { int t = threadIdx.x; asm volatile("" : "+v"(t)); return t; }
DI int crow(int i, int h) { return (i & 3) + 8 * (i >> 2) + 4 * h; }


#define XB_TMO      128
#define XB_XCNT(j)  (256  + 64 * (j))
#define XB_XSUB(j)  (1280 + 64 * (j))
#define XB_XGEN(j)  (2304 + 64 * (j))
#define XB_TOP      3328
#define XB_TOPGEN   3392
#define XCD_BAR_WORDS 3456
#define XB_SPIN_CAP (1u << 22)
DI unsigned xb_ld(unsigned* p)              { return __hip_atomic_load(p, __ATOMIC_RELAXED, __HIP_MEMORY_SCOPE_AGENT); }
DI unsigned xb_add(unsigned* p, unsigned v) { return __hip_atomic_fetch_add(p, v, __ATOMIC_RELAXED, __HIP_MEMORY_SCOPE_AGENT); }
DI unsigned xb_xcc_id() { return (unsigned)__builtin_amdgcn_s_getreg((3 << 11) | 20) & 0xFu; }
#define XB_SPIN(cond, bar) do { unsigned _sp = 0; while (cond) { __builtin_amdgcn_s_sleep(1); \
    if ((++_sp & 255u) == 0u) { if (xb_ld(&(bar)[XB_TMO])) break; if (_sp > XB_SPIN_CAP) { atomicAdd(&(bar)[XB_TMO], 1u); break; } } } } while (0)
struct XcdBarrier { unsigned* bar; unsigned x; volatile LAS unsigned* st; };
DI XcdBarrier xcd_barrier_post(unsigned* bar, volatile LAS unsigned* st) {
    XcdBarrier b; b.bar = bar; b.x = xb_xcc_id(); b.st = st;
    if (threadIdx.x == 0) (void)xb_add(&bar[XB_XCNT(b.x)], 1u);
    return b;
}
DI void xcd_barrier_complete(unsigned* bar, unsigned x, unsigned& nloc, unsigned& nx) {
    const unsigned G = gridDim.x * gridDim.y * gridDim.z;
    unsigned sum, cnt, mine, sp = 0u;
    for (;;) {
        sum = 0u; cnt = 0u; mine = 0u;
#pragma unroll
        for (unsigned j = 0; j < 16; ++j) { const unsigned c = xb_ld(&bar[XB_XCNT(j)]); sum += c; cnt += (c > 0u) ? 1u : 0u; mine = (j == x) ? c : mine; }
        if (sum == G) break;
        __builtin_amdgcn_s_sleep(1);
        if ((++sp & 255u) == 0u) { if (xb_ld(&bar[XB_TMO])) break; if (sp > XB_SPIN_CAP) { atomicAdd(&bar[XB_TMO], 1u); break; } }
    }
    nloc = mine > 0u ? mine : 1u; nx = cnt > 0u ? cnt : 1u;
}
DI void xcd_barrier(const XcdBarrier& b) {
    asm volatile("s_waitcnt vmcnt(0)" ::: "memory");
    __syncthreads();
    if (threadIdx.x == 0) {
        unsigned* bar = b.bar;
        __builtin_amdgcn_s_waitcnt(0);
        unsigned nloc = b.st[0], nx = b.st[1];
        if (nloc == 0u) { xcd_barrier_complete(bar, b.x, nloc, nx); b.st[0] = nloc; b.st[1] = nx; }
        const unsigned old = xb_add(&bar[XB_XSUB(b.x)], 1u);
        const unsigned gen = old / nloc;
        if (old + 1u == (gen + 1u) * nloc) {
            __builtin_amdgcn_fence(__ATOMIC_RELEASE, "agent");
            asm volatile("s_waitcnt vmcnt(0)" ::: "memory");
            const unsigned og = xb_add(&bar[XB_TOP], 1u);
            const unsigned tg = og / nx;
            if (og + 1u == (tg + 1u) * nx) xb_add(&bar[XB_TOPGEN], 1u);
            else XB_SPIN(xb_ld(&bar[XB_TOPGEN]) == tg, bar);
            __builtin_amdgcn_fence(__ATOMIC_ACQUIRE, "agent");
            xb_add(&bar[XB_XGEN(b.x)], 1u);
            asm volatile("s_waitcnt vmcnt(0)" ::: "memory");
        } else {
            XB_SPIN(xb_ld(&bar[XB_XGEN(b.x)]) == gen, bar);
            __builtin_amdgcn_fence(__ATOMIC_ACQUIRE, "agent");
            asm volatile("s_waitcnt vmcnt(0)" ::: "memory");
        }
    }
    __syncthreads();
}

namespace g8 {
constexpr int BM = 256, BK = 64, HALF = 128, HTB = HALF * BK * 2, NXCD = 8, WGM = 4;
DI int lds_byte(int r, int c) { const int st = (r >> 4) * 2 + (c >> 5), rr = r & 15, cc = c & 31, ob = rr * 64 + cc * 2; return st * 1024 + (ob ^ (((ob >> 9) & 1) << 5)); }
DI void stage_rc(int b, int& R, int& C) { const int st = b / 1024, sb = b % 1024, swz = sb ^ (((sb >> 9) & 1) << 5); R = (st >> 1) * 16 + swz / 64; C = (st & 1) * 32 + (swz % 64) / 2; }
DI int perm32(int rho) { const int n = rho >> 4, i = rho & 15; return 8 * (i >> 2) + 4 * n + (i & 3); }
struct Unit { int pm, pn, kt0, nt, part; };
struct Gemm { const bf16_t* A; int lda; const bf16_t* Bt; int M, N, K; };
struct StaticOrder {
    int nM, nN, nwg, G, c, ntk;
    DI void init(int M, int N, int K, int G_, int c_) { nM = M / BM; nN = N / BM; nwg = nM * nN; G = G_; c = c_; ntk = K / BK; }
    DI bool next(int i, Unit& u) const {
        const long L = (long)i * G + c; if (L >= nwg) return false;
        int wgid = (int)L; { const int q = nwg / NXCD, r = nwg % NXCD, xcd = wgid % NXCD, off = wgid / NXCD; wgid = (xcd < r ? xcd * (q + 1) : r * (q + 1) + (xcd - r) * q) + off; }
        const int nig = WGM * nN, gid = wgid / nig, fm = gid * WGM, gsz = (nM - fm) < WGM ? (nM - fm) : WGM;
        u.pm = fm + ((wgid % nig) % gsz); u.pn = (wgid % nig) / gsz; u.kt0 = 0; u.nt = ntk; u.part = 0; return true;
    }
};
struct SplitOrder {
    int ntk, c;
    DI void init(int K, int c_) { ntk = K / BK; c = c_; }
    DI bool next(int i, Unit& u) const {
        const int xcd = c & 7, slot = c >> 3;
        if (i < 2) { const int L = i * 256 + xcd * 32 + slot; u.pm = L >> 2; u.pn = L & 3; u.kt0 = 0; u.nt = ntk; u.part = 0; return true; }
        if (i == 2) { const int L = 512 + xcd * 16 + (slot >> 1), hf = slot & 1; u.pm = L >> 2; u.pn = L & 3; u.kt0 = hf * (ntk >> 1); u.nt = ntk >> 1; u.part = hf; return true; }
        return false;
    }
};
struct EpiBf16 {
    bf16_t* O; int ldc; bf16_t* O2 = nullptr;
    DI void operator()(const f32x4 (&acc)[2][2][4][2], const Unit& u, int wr, int wc, int fr, int fq) const {
        const int row0 = u.pm * BM + wr * 64 + fr, col0 = u.pn * BM + wc * 32 + 8 * fq;
#pragma unroll
        for (int ai = 0; ai < 2; ++ai)
#pragma unroll
            for (int m = 0; m < 4; ++m) { bf16_t* rowp = (u.part ? O2 - (size_t)32768 * ldc : O) + (size_t)(row0 + ai * HALF + m * 16) * ldc + col0;
#pragma unroll
                for (int bj = 0; bj < 2; ++bj) { const f32x4 v0 = acc[ai][bj][m][0], v1 = acc[ai][bj][m][1];
                    u32x4 w; w.x = pk2(v0[0], v0[1]); w.y = pk2(v0[2], v0[3]); w.z = pk2(v1[0], v1[1]); w.w = pk2(v1[2], v1[3]);
                    *(u32x4*)(rowp + bj * HALF) = w; } }
    }
};
struct EpiSwiGLU {
    bf16_t* O;
    DI void operator()(const f32x4 (&acc)[2][2][4][2], const Unit& u, int wr, int wc, int fr, int fq) const {
        const int row0 = u.pm * BM + wr * 64 + fr, col0 = u.pn * HALF + wc * 32 + 8 * fq;
#pragma unroll
        for (int ai = 0; ai < 2; ++ai)
#pragma unroll
            for (int m = 0; m < 4; ++m) { bf16_t* rowp = O + (size_t)(row0 + ai * HALF + m * 16) * DFF + col0;
                float r[8];
#pragma unroll
                for (int n = 0; n < 2; ++n)
#pragma unroll
                    for (int j = 0; j < 4; ++j) { const float g = acc[ai][0][m][n][j], up = acc[ai][1][m][n][j]; r[4 * n + j] = silu_f(g) * up; }
                u32x4 w; w.x = pk2(r[0], r[1]); w.y = pk2(r[2], r[3]); w.z = pk2(r[4], r[5]); w.w = pk2(r[6], r[7]);
                *(u32x4*)rowp = w; }
    }
};

template <class Epi, class Order>
DI void gemm_phase(LAS unsigned char* lds, const Gemm g, const Order& S, const Epi& E) {
    const int tid = otid(), wid = __builtin_amdgcn_readfirstlane(tid >> 6), lane = tid & 63, wr = wid >> 2, wc = wid & 3, fr = lane & 15, fq = lane >> 4;
    const int K = g.K, lda = g.lda;
    unsigned voffA[2], voffB[2];
#pragma unroll
    for (int i = 0; i < 2; ++i) { int R, C; stage_rc(tid * 16 + i * 8192, R, C); const int Rb = (R & ~31) + perm32(R & 31);
        voffA[i] = (unsigned)(R * lda + C) * 2u; voffB[i] = (unsigned)(Rb * K + C) * 2u; }
    const size_t kstep = (size_t)(BK * 2);
    const size_t hstepA = (size_t)HALF * lda * 2, hstepB = (size_t)HALF * K * 2;
    const size_t tstepA = 2 * hstepA, tstepB = 2 * hstepB;
    const unsigned ldsw = (unsigned)wid * 1024u;
    const int aoff = lds_byte(wr * 64 + fr, fq * 8), boff = lds_byte(wc * 32 + fr, fq * 8);
#define G8_SA(b, h) (((b) * 2 + (h)) * HTB)
#define G8_SB(b, h) ((4 + (b) * 2 + (h)) * HTB)
#define G8_STAGE(bufoff, gbase, voff) do { _Pragma("unroll") for (int _i = 0; _i < 2; ++_i) \
        __builtin_amdgcn_global_load_lds((const unsigned*)((const char*)(gbase) + (voff)[_i]), (LAS unsigned*)(lds + (bufoff) + ldsw + _i * 8192), 16, 0, 0); } while (0)
#define G8_LDA(dst, b, h) do { _Pragma("unroll") for (int m = 0; m < 4; ++m) _Pragma("unroll") for (int k = 0; k < 2; ++k) dst[m][k] = *(const LAS bf16x8*)(lds + G8_SA(b, h) + aoff + m * 2048 + k * 1024); } while (0)
#define G8_LDB(dst, b, h) do { _Pragma("unroll") for (int n = 0; n < 2; ++n) _Pragma("unroll") for (int k = 0; k < 2; ++k) dst[n][k] = *(const LAS bf16x8*)(lds + G8_SB(b, h) + boff + n * 2048 + k * 1024); } while (0)
#define G8_MMA(ai, bj, At, Bt) do { __builtin_amdgcn_s_setprio(1); _Pragma("unroll") for (int m = 0; m < 4; ++m) _Pragma("unroll") for (int n = 0; n < 2; ++n) _Pragma("unroll") for (int k = 0; k < 2; ++k) \
        acc[ai][bj][m][n] = __builtin_amdgcn_mfma_f32_16x16x32_bf16(Bt[n][k], At[m][k], acc[ai][bj][m][n], 0, 0, 0); __builtin_amdgcn_s_setprio(0); } while (0)
#define G8_WAIT_V(n) asm volatile("s_waitcnt vmcnt(" #n ")" ::: "memory")
#define G8_WAIT_L(n) asm volatile("s_waitcnt lgkmcnt(" #n ")" ::: "memory")
#define G8_BAR __builtin_amdgcn_s_barrier()
#define G8_SCHED __builtin_amdgcn_sched_barrier(0)
    Unit cur, nxt; int ui = 0;
    if (!S.next(0, cur)) return;
    f32x4 acc[2][2][4][2];
#pragma unroll
    for (int a = 0; a < 2; ++a)
#pragma unroll
        for (int b = 0; b < 2; ++b)
#pragma unroll
            for (int m = 0; m < 4; ++m)
#pragma unroll
                for (int n = 0; n < 2; ++n) acc[a][b][m][n] = (f32x4){0.f, 0.f, 0.f, 0.f};
    bf16x8 At[4][2], B0[2][2], B1[2][2];
    const char* cA = (const char*)g.A + (size_t)cur.pm * tstepA + (size_t)cur.kt0 * kstep; const char* cB = (const char*)g.Bt + (size_t)cur.pn * tstepB + (size_t)cur.kt0 * kstep;
    G8_STAGE(G8_SB(0, 0), cB, voffB); G8_STAGE(G8_SB(0, 1), cB + hstepB, voffB); G8_STAGE(G8_SA(0, 0), cA, voffA); G8_STAGE(G8_SA(0, 1), cA + hstepA, voffA);
    if (wr == 1) G8_BAR;
    G8_WAIT_V(2); G8_BAR;
    G8_STAGE(G8_SB(1, 0), cB + kstep, voffB); G8_STAGE(G8_SA(1, 0), cA + kstep, voffA); G8_STAGE(G8_SB(1, 1), cB + hstepB + kstep, voffB);
    G8_WAIT_V(6); G8_BAR;
    for (;;) {
        const bool has_next = S.next(ui + 1, nxt);
        const char* nA = has_next ? (const char*)g.A + (size_t)nxt.pm * tstepA + (size_t)nxt.kt0 * kstep : cA; const char* nB = has_next ? (const char*)g.Bt + (size_t)nxt.pn * tstepB + (size_t)nxt.kt0 * kstep : cB;
        const int nt = cur.nt;
        for (int t = 0; t < nt; t += 2) {
            const bool last = (t == nt - 2);
            const char* a1 = cA + (size_t)(t + 1) * kstep;
            const char* a2 = last ? nA : cA + (size_t)(t + 2) * kstep; const char* b2 = last ? nB : cB + (size_t)(t + 2) * kstep;
            const char* a3 = a2 + kstep; const char* b3 = b2 + kstep;
            G8_LDB(B0, 0, 0); G8_LDB(B1, 0, 1); G8_SCHED; G8_LDA(At, 0, 0); G8_STAGE(G8_SA(1, 1), a1 + hstepA, voffA);
            G8_WAIT_V(8); G8_WAIT_L(0); G8_BAR; G8_MMA(0, 0, At, B0); G8_MMA(0, 1, At, B1); G8_BAR; G8_SCHED;
            G8_LDA(At, 0, 1); G8_STAGE(G8_SB(0, 0), b2, voffB); G8_STAGE(G8_SB(0, 1), b2 + hstepB, voffB); G8_STAGE(G8_SA(0, 0), a2, voffA);
            G8_WAIT_V(8); G8_WAIT_L(0); G8_BAR; G8_MMA(1, 0, At, B0); G8_MMA(1, 1, At, B1); G8_BAR; G8_SCHED;
            G8_LDB(B0, 1, 0); G8_LDB(B1, 1, 1); G8_SCHED; G8_LDA(At, 1, 0); G8_STAGE(G8_SA(0, 1), a2 + hstepA, voffA);
            G8_WAIT_V(8); G8_WAIT_L(0); G8_BAR; G8_MMA(0, 0, At, B0); G8_MMA(0, 1, At, B1); G8_BAR; G8_SCHED;
            G8_LDA(At, 1, 1); G8_STAGE(G8_SB(1, 0), b3, voffB); G8_STAGE(G8_SB(1, 1), b3 + hstepB, voffB); G8_STAGE(G8_SA(1, 0), a3, voffA);
            G8_WAIT_V(8); G8_WAIT_L(0); G8_BAR; G8_MMA(1, 0, At, B0); G8_MMA(1, 1, At, B1); G8_BAR; G8_SCHED;
        }
        if (wr == 0) G8_BAR;
        E(acc, cur, wr, wc, fr, fq);
        if (!has_next) break;
#pragma unroll
        for (int a = 0; a < 2; ++a)
#pragma unroll
            for (int b = 0; b < 2; ++b)
#pragma unroll
                for (int m = 0; m < 4; ++m)
#pragma unroll
                    for (int n = 0; n < 2; ++n) acc[a][b][m][n] = (f32x4){0.f, 0.f, 0.f, 0.f};
        cur = nxt; cA = nA; cB = nB; ++ui;
        if (wr == 1) G8_BAR;
    }
    G8_WAIT_V(0);
    G8_BAR;
}
}

DI void phase_mod(const float* c, const float* c_ctx, const float* mod_w, const float* mod_b, float* mod, LAS float* lds) {
    const int tid = otid(), lane = tid & 63, wave = tid >> 6;
    LAS float* sc = lds;
    LAS float* red = lds + 9 * 1024;
    for (int idx = tid; idx < 9 * 1024; idx += 512) { const int ci = idx >> 10, k = idx & 1023; const float v = (ci == 0) ? c_ctx[k] : c[(ci - 1) * 1024 + k]; sc[idx] = silu_f(v); }
    __syncthreads();
    for (int item = blockIdx.x; item < 2 * 144; item += gridDim.x) {
        const int l = item / 144, j = (item % 144) * 64 + lane;
        float a0 = 0, a1 = 0, a2 = 0, a3 = 0, a4 = 0, a5 = 0, a6 = 0, a7 = 0, a8 = 0;
        const float* wp = mod_w + ((size_t)l * 1024 + wave * 128) * 9216 + j;
        LAS const float* sp = sc + wave * 128;
#pragma unroll 32
        for (int k = 0; k < 128; ++k) { const float w = wp[(size_t)k * 9216];
            a0 += sp[k] * w; a1 += sp[1024 + k] * w; a2 += sp[2048 + k] * w; a3 += sp[3072 + k] * w; a4 += sp[4096 + k] * w;
            a5 += sp[5120 + k] * w; a6 += sp[6144 + k] * w; a7 += sp[7168 + k] * w; a8 += sp[8192 + k] * w; }
        LAS float* rp = red + wave * 576 + lane;
        rp[0] = a0; rp[64] = a1; rp[128] = a2; rp[192] = a3; rp[256] = a4; rp[320] = a5; rp[384] = a6; rp[448] = a7; rp[512] = a8;
        __syncthreads();
        for (int e = tid; e < 576; e += 512) { float s = 0.f;
#pragma unroll
            for (int w2 = 0; w2 < 8; ++w2) s += red[w2 * 576 + e];
            const int ci = e >> 6, jj = (item % 144) * 64 + (e & 63);
            mod[((size_t)l * 9 + ci) * 9216 + jj] = s + mod_b[(size_t)l * 9216 + jj]; }
        __syncthreads();
    }
}
struct WItem { const float* W; bf16_t* WT; int K, N, mode, item; float qs; };
DI void witem_load(const WItem& d, f32x4 (&v)[8], int lane) {
    const int nblk = d.N / 32, kb = d.item / nblk, nb = d.item % nblk, k0 = 64 * kb, n0 = 32 * nb;
    const int lr = lane >> 3, c4 = (lane & 7) * 4;
#pragma unroll
    for (int i = 0; i < 8; ++i) v[i] = __builtin_nontemporal_load((const f32x4*)(d.W + (size_t)(k0 + 8 * i + lr) * d.N + n0 + c4));
}
DI void witem_finish(const WItem& d, const f32x4 (&v)[8], LAS float* scr, int lane) {
    const int nblk = d.N / 32, kb = d.item / nblk, nb = d.item % nblk, k0 = 64 * kb, n0 = 32 * nb;
    const int lr = lane >> 3, c4 = (lane & 7) * 4;
    const float cs = (n0 < 1024) ? d.qs : 1.f;
#pragma unroll
    for (int i = 0; i < 8; ++i) { LAS float* s = scr + (8 * i + lr) * 33 + c4; s[0] = v[i].x * cs; s[1] = v[i].y * cs; s[2] = v[i].z * cs; s[3] = v[i].w * cs; }
    LDS_WAIT();
    int d0 = n0;
    if (d.mode == 1) { const int bj = n0 / DFF, rem = n0 % DFF; d0 = 256 * (rem / 128) + 128 * bj + (rem % 128); }
    const int c = lane & 7;
#pragma unroll
    for (int j = 0; j < 4; ++j) { const int n = (lane >> 3) + 8 * j; LAS const float* s = scr + (8 * c) * 33 + n;
        u32x4 o; o.x = pk2(s[0 * 33], s[1 * 33]); o.y = pk2(s[2 * 33], s[3 * 33]); o.z = pk2(s[4 * 33], s[5 * 33]); o.w = pk2(s[6 * 33], s[7 * 33]);
        *(u32x4*)(d.WT + (size_t)(d0 + n) * d.K + k0 + 8 * c) = o; }
    LDS_WAIT();
}
struct Params { const float* in[26]; float* out; unsigned char* ws; };

DI WItem witem_of(const Params& p, int it) {
    constexpr int I_FIN = 16 * 176, I_FOUT = 44 * 32, I_ABIN = 16 * 88, I_ABOUT = 16 * 32, I_NAQKV = 16 * 96;
    WItem d; d.qs = 1.f; d.mode = 0;
    int r = it;
    if (r < 4 * I_FIN) { const int mi = r / I_FIN; d.W = p.in[14] + (size_t)mi * 1024 * 5632; d.K = 1024; d.N = 5632; d.WT = (bf16_t*)(p.ws + WS_FIN + mi * SZ_FIN); d.mode = 1; d.item = r % I_FIN; return d; } r -= 4 * I_FIN;
    if (r < 4 * I_FOUT) { const int mi = r / I_FOUT; d.W = p.in[15] + (size_t)mi * 2816 * 1024; d.K = 2816; d.N = 1024; d.WT = (bf16_t*)(p.ws + WS_FOUT + mi * SZ_FOUT); d.item = r % I_FOUT; return d; } r -= 4 * I_FOUT;
    if (r < I_ABIN) { d.W = p.in[16]; d.K = 1024; d.N = 2816; d.WT = (bf16_t*)(p.ws + WS_ABIN); d.item = r; return d; } r -= I_ABIN;
    if (r < I_ABOUT) { d.W = p.in[17]; d.K = 1024; d.N = 1024; d.WT = (bf16_t*)(p.ws + WS_ABOUT); d.item = r; return d; } r -= I_ABOUT;
    if (r < I_NAQKV) { d.W = p.in[23]; d.K = 1024; d.N = 3072; d.WT = (bf16_t*)(p.ws + WS_NAQKV); d.item = r; d.qs = 0.125f * LOG2E; return d; } r -= I_NAQKV;
    d.W = p.in[24]; d.K = 1024; d.N = 1024; d.WT = (bf16_t*)(p.ws + WS_NAOUT); d.item = r; return d;
}
DI void phase_weights(const Params& p, LAS unsigned char* lds) {
    const int tid = otid(), lane = tid & 63, wave = tid >> 6;
    LAS float* scr = (LAS float*)(lds + 57344 + wave * 8704);
    const int gw = blockIdx.x * 8 + wave, NGW = gridDim.x * 8;
    constexpr int NITEMS = 4 * (16 * 176) + 4 * (44 * 32) + 16 * 88 + 16 * 32 + 16 * 96 + 16 * 32;
    for (int it = gw; it < NITEMS; it += 2 * NGW) {
        const int it2 = it + NGW; const bool has2 = it2 < NITEMS;
        const WItem dA = witem_of(p, it); const WItem dB = witem_of(p, has2 ? it2 : it);
        f32x4 vA[8], vB[8];
        witem_load(dA, vA, lane);
        if (has2) witem_load(dB, vB, lane);
        witem_finish(dA, vA, scr, lane);
        if (has2) witem_finish(dB, vB, scr, lane);
    }
}

template <bool HAS_Y, bool HAS_H, int XS, int XD>
DI void row_phase(const float* x0, const float* x1, float* X, const bf16_t* Y, const bf16_t* Y2, bf16_t* H,
                  const float* modg, int sg, float wgt, const float* gpost, const float* modn, int sn, const float* gpre) {
    const int tid = otid(), lane = tid & 63, gw = blockIdx.x * 8 + (tid >> 6), NGW = gridDim.x * 8;
    if (NGW == 2048) {
        for (int tA = gw; tA < T; tA += 4096) {
            const int tB = tA + 2048;
            const int ci = tA < TC ? 0 : 1 + ((tA - TC) >> 12);
            f32x4 vA[4], vB[4], cg[4], ca[4], cs[4];
            u32x2 yA[4], yB[4], zA[4], zB[4];
            if (XS == 0) {
                const float* xa = (tA < TC) ? x0 + (size_t)tA * 1024 : x1 + (size_t)(tA - TC) * 1024;
                const float* xb = (tB < TC) ? x0 + (size_t)tB * 1024 : x1 + (size_t)(tB - TC) * 1024;
#pragma unroll
                for (int j = 0; j < 4; ++j) { vA[j] = *(const f32x4*)(xa + 4 * lane + 256 * j); vB[j] = *(const f32x4*)(xb + 4 * lane + 256 * j); }
            } else {
                const bf16_t* xa = (const bf16_t*)X + (size_t)tA * 2048 + 1024; const bf16_t* xb = (const bf16_t*)X + (size_t)tB * 2048 + 1024;
#pragma unroll
                for (int j = 0; j < 4; ++j) { const u32x2 ra = *(const u32x2*)(xa + 4 * lane + 256 * j), rb = *(const u32x2*)(xb + 4 * lane + 256 * j);
                    vA[j] = (f32x4){bflo(ra.x), bfhi(ra.x), bflo(ra.y), bfhi(ra.y)}; vB[j] = (f32x4){bflo(rb.x), bfhi(rb.x), bflo(rb.y), bfhi(rb.y)}; }
            }
            if (HAS_Y) {
#pragma unroll
                for (int j = 0; j < 4; ++j) { yA[j] = *(const u32x2*)(Y + (size_t)tA * 1024 + 4 * lane + 256 * j); yB[j] = *(const u32x2*)(Y + (size_t)tB * 1024 + 4 * lane + 256 * j);
                    zA[j] = (tA >= 32768) ? *(const u32x2*)(Y2 + (size_t)(tA - 32768) * 1024 + 4 * lane + 256 * j) : (u32x2){0u, 0u};
                    zB[j] = (tB >= 32768) ? *(const u32x2*)(Y2 + (size_t)(tB - 32768) * 1024 + 4 * lane + 256 * j) : (u32x2){0u, 0u}; }
                const float* gate = modg + (size_t)ci * 9216 + sg * 1024;
#pragma unroll
                for (int j = 0; j < 4; ++j) cg[j] = *(const f32x4*)(gate + 4 * lane + 256 * j) * *(const f32x4*)(gpost + 4 * lane + 256 * j);
            }
            if (HAS_H) {
                const float* shift = modn + (size_t)ci * 9216 + sn * 1024; const float* scale = shift + 1024;
#pragma unroll
                for (int j = 0; j < 4; ++j) { cs[j] = *(const f32x4*)(shift + 4 * lane + 256 * j); ca[j] = *(const f32x4*)(gpre + 4 * lane + 256 * j) * (*(const f32x4*)(scale + 4 * lane + 256 * j) + 1.f); }
            }
            if (HAS_Y) {
                f32x4 ya[4], yb[4]; float sa = 0.f, sb = 0.f;
#pragma unroll
                for (int j = 0; j < 4; ++j) {
                    ya[j] = (f32x4){bflo(yA[j].x) + bflo(zA[j].x), bfhi(yA[j].x) + bfhi(zA[j].x), bflo(yA[j].y) + bflo(zA[j].y), bfhi(yA[j].y) + bfhi(zA[j].y)};
                    yb[j] = (f32x4){bflo(yB[j].x) + bflo(zB[j].x), bfhi(yB[j].x) + bfhi(zB[j].x), bflo(yB[j].y) + bflo(zB[j].y), bfhi(yB[j].y) + bfhi(zB[j].y)};
                    sa += (ya[j].x * ya[j].x + ya[j].y * ya[j].y) + (ya[j].z * ya[j].z + ya[j].w * ya[j].w);
                    sb += (yb[j].x * yb[j].x + yb[j].y * yb[j].y) + (yb[j].z * yb[j].z + yb[j].w * yb[j].w); }
#pragma unroll
                for (int o = 32; o >= 1; o >>= 1) { sa += __shfl_xor(sa, o); sb += __shfl_xor(sb, o); }
                const float ra = rsqrtf(sa * (1.f / 1024.f) + 1e-6f) * wgt, rb = rsqrtf(sb * (1.f / 1024.f) + 1e-6f) * wgt;
#pragma unroll
                for (int j = 0; j < 4; ++j) { vA[j] = vA[j] + cg[j] * (ya[j] * ra); vB[j] = vB[j] + cg[j] * (yb[j] * rb); }
            }
            if (XD == 2) {
#pragma unroll
                for (int j = 0; j < 4; ++j) { *(f32x4*)(X + (size_t)tA * 1024 + 4 * lane + 256 * j) = vA[j]; *(f32x4*)(X + (size_t)tB * 1024 + 4 * lane + 256 * j) = vB[j]; }
            }
            if (XD == 1) {
                bf16_t* xa = (bf16_t*)X + (size_t)tA * 2048 + 1024; bf16_t* xb = (bf16_t*)X + (size_t)tB * 2048 + 1024;
#pragma unroll
                for (int j = 0; j < 4; ++j) { u32x2 oa, ob; oa.x = pk2(vA[j].x, vA[j].y); oa.y = pk2(vA[j].z, vA[j].w); ob.x = pk2(vB[j].x, vB[j].y); ob.y = pk2(vB[j].z, vB[j].w);
                    *(u32x2*)(xa + 4 * lane + 256 * j) = oa; *(u32x2*)(xb + 4 * lane + 256 * j) = ob;
                    vA[j] = (f32x4){bflo(oa.x), bfhi(oa.x), bflo(oa.y), bfhi(oa.y)}; vB[j] = (f32x4){bflo(ob.x), bfhi(ob.x), bflo(ob.y), bfhi(ob.y)}; }
            }
            if (HAS_H) {
                float sa = 0.f, sb = 0.f;
#pragma unroll
                for (int j = 0; j < 4; ++j) { sa += (vA[j].x * vA[j].x + vA[j].y * vA[j].y) + (vA[j].z * vA[j].z + vA[j].w * vA[j].w);
                    sb += (vB[j].x * vB[j].x + vB[j].y * vB[j].y) + (vB[j].z * vB[j].z + vB[j].w * vB[j].w); }
#pragma unroll
                for (int o = 32; o >= 1; o >>= 1) { sa += __shfl_xor(sa, o); sb += __shfl_xor(sb, o); }
                const float ra = rsqrtf(sa * (1.f / 1024.f) + 1e-6f), rb = rsqrtf(sb * (1.f / 1024.f) + 1e-6f);
#pragma unroll
                for (int j = 0; j < 4; ++j) {
                    const f32x4 ha = (vA[j] * ra) * ca[j] + cs[j], hb = (vB[j] * rb) * ca[j] + cs[j];
                    u32x2 oa, ob; oa.x = pk2(ha.x, ha.y); oa.y = pk2(ha.z, ha.w); ob.x = pk2(hb.x, hb.y); ob.y = pk2(hb.z, hb.w);
                    *(u32x2*)(H + (size_t)tA * 1024 + 4 * lane + 256 * j) = oa; *(u32x2*)(H + (size_t)tB * 1024 + 4 * lane + 256 * j) = ob; }
            }
        }
        return;
    }
    for (int tA = gw; tA < T; tA += 2 * NGW) {
        const int tB = tA + NGW; const bool hasB = tB < T;
        f32x4 vA[4], vB[4]; u32x2 yA[4], yB[4], zA[4], zB[4];
#define ROW_LOAD(t, v, yr, zr) do { \
        if (XS == 0) { const float* xr = ((t) < TC) ? x0 + (size_t)(t) * 1024 : x1 + (size_t)((t) - TC) * 1024; \
            _Pragma("unroll") for (int j = 0; j < 4; ++j) v[j] = *(const f32x4*)(xr + 4 * lane + 256 * j); } \
        else { const bf16_t* xb = (const bf16_t*)X + (size_t)(t) * 2048 + 1024; \
            _Pragma("unroll") for (int j = 0; j < 4; ++j) { const u32x2 xr2 = *(const u32x2*)(xb + 4 * lane + 256 * j); v[j] = (f32x4){bflo(xr2.x), bfhi(xr2.x), bflo(xr2.y), bfhi(xr2.y)}; } } \
        if (HAS_Y) { _Pragma("unroll") for (int j = 0; j < 4; ++j) { yr[j] = *(const u32x2*)(Y + (size_t)(t) * 1024 + 4 * lane + 256 * j); \
            zr[j] = ((t) >= 32768) ? *(const u32x2*)(Y2 + (size_t)((t) - 32768) * 1024 + 4 * lane + 256 * j) : (u32x2){0u, 0u}; } } } while (0)
        ROW_LOAD(tA, vA, yA, zA);
        if (hasB) ROW_LOAD(tB, vB, yB, zB);
#undef ROW_LOAD
#define ROW_COMPUTE(t, v, yr, zr) do { \
        const int ci = (t) < TC ? 0 : 1 + (((t) - TC) >> 12); \
        if (HAS_Y) { f32x4 y[4]; float ss = 0.f; \
            _Pragma("unroll") for (int j = 0; j < 4; ++j) { \
                y[j] = (f32x4){bflo(yr[j].x) + bflo(zr[j].x), bfhi(yr[j].x) + bfhi(zr[j].x), bflo(yr[j].y) + bflo(zr[j].y), bfhi(yr[j].y) + bfhi(zr[j].y)}; \
                ss += (y[j].x * y[j].x + y[j].y * y[j].y) + (y[j].z * y[j].z + y[j].w * y[j].w); } \
            ss = wave_sum(ss); \
            const float r = rsqrtf(ss * (1.f / 1024.f) + 1e-6f) * wgt; \
            const float* gate = modg + (size_t)ci * 9216 + sg * 1024; \
            _Pragma("unroll") for (int j = 0; j < 4; ++j) { const f32x4 g = *(const f32x4*)(gate + 4 * lane + 256 * j); const f32x4 gp = *(const f32x4*)(gpost + 4 * lane + 256 * j); \
                v[j] = v[j] + (g * gp) * (y[j] * r); } } \
        if (XD == 2) { float* xo = X + (size_t)(t) * 1024; \
            _Pragma("unroll") for (int j = 0; j < 4; ++j) *(f32x4*)(xo + 4 * lane + 256 * j) = v[j]; } \
        if (XD == 1) { bf16_t* xo = (bf16_t*)X + (size_t)(t) * 2048 + 1024; \
            _Pragma("unroll") for (int j = 0; j < 4; ++j) { u32x2 o; o.x = pk2(v[j].x, v[j].y); o.y = pk2(v[j].z, v[j].w); *(u32x2*)(xo + 4 * lane + 256 * j) = o; \
                v[j] = (f32x4){bflo(o.x), bfhi(o.x), bflo(o.y), bfhi(o.y)}; } } \
        if (HAS_H) { float ss = 0.f; \
            _Pragma("unroll") for (int j = 0; j < 4; ++j) ss += (v[j].x * v[j].x + v[j].y * v[j].y) + (v[j].z * v[j].z + v[j].w * v[j].w); \
            ss = wave_sum(ss); \
            const float r = rsqrtf(ss * (1.f / 1024.f) + 1e-6f); \
            const float* shift = modn + (size_t)ci * 9216 + sn * 1024; const float* scale = shift + 1024; \
            bf16_t* ho = H + (size_t)(t) * 1024; \
            _Pragma("unroll") for (int j = 0; j < 4; ++j) { const f32x4 sh = *(const f32x4*)(shift + 4 * lane + 256 * j), scl = *(const f32x4*)(scale + 4 * lane + 256 * j), gp = *(const f32x4*)(gpre + 4 * lane + 256 * j); \
                const f32x4 hv = (v[j] * r) * gp * (scl + 1.f) + sh; \
                u32x2 o; o.x = pk2(hv.x, hv.y); o.y = pk2(hv.z, hv.w); \
                *(u32x2*)(ho + 4 * lane + 256 * j) = o; } } } while (0)
        ROW_COMPUTE(tA, vA, yA, zA);
        if (hasB) ROW_COMPUTE(tB, vB, yB, zB);
#undef ROW_COMPUTE
    }
}

template <class SrcF>
DI void wave_transpose64(LAS unsigned short* scr, SrcF src, bf16_t* dst, size_t ldd, int lane) {
    const int lr = lane >> 3, ch = lane & 7;
    u32x4 v[8];
#pragma unroll
    for (int i = 0; i < 8; ++i) v[i] = src(8 * i + lr, ch);
#pragma unroll
    for (int i = 0; i < 8; ++i) { LAS unsigned* s = (LAS unsigned*)(scr + (8 * i + lr) * 66 + 8 * ch); s[0] = v[i].x; s[1] = v[i].y; s[2] = v[i].z; s[3] = v[i].w; }
    LDS_WAIT();
#pragma unroll
    for (int j = 0; j < 8; ++j) { const int d = lr + 8 * j; LAS const unsigned short* s = scr + (8 * ch) * 66 + d;
        u32x4 o;
        o.x = (unsigned)s[0 * 66] | ((unsigned)s[1 * 66] << 16); o.y = (unsigned)s[2 * 66] | ((unsigned)s[3 * 66] << 16);
        o.z = (unsigned)s[4 * 66] | ((unsigned)s[5 * 66] << 16); o.w = (unsigned)s[6 * 66] | ((unsigned)s[7 * 66] << 16);
        *(u32x4*)(dst + (size_t)d * ldd + 8 * ch) = o; }
    LDS_WAIT();
}
struct TItem { const void* src; size_t lds_; int f32; bf16_t* dst; size_t ldd; };
DI void titem_load(const TItem& d, u32x4 (&v)[8], int lane) {
    const int lr = lane >> 3, ch = lane & 7;
    if (d.f32) {
#pragma unroll
        for (int i = 0; i < 8; ++i) { const float* p = (const float*)d.src + (size_t)(8 * i + lr) * d.lds_ + 8 * ch; const f32x4 a = *(const f32x4*)p, b = *(const f32x4*)(p + 4);
            v[i].x = pk2(a.x, a.y); v[i].y = pk2(a.z, a.w); v[i].z = pk2(b.x, b.y); v[i].w = pk2(b.z, b.w); }
    } else {
#pragma unroll
        for (int i = 0; i < 8; ++i) v[i] = *(const u32x4*)((const bf16_t*)d.src + (size_t)(8 * i + lr) * d.lds_ + 8 * ch);
    }
}
DI void titem_finish(const TItem& d, const u32x4 (&v)[8], LAS unsigned short* scr, int lane) {
    const int lr = lane >> 3, ch = lane & 7;
#pragma unroll
    for (int i = 0; i < 8; ++i) { LAS unsigned* s = (LAS unsigned*)(scr + (8 * i + lr) * 66 + 8 * ch); s[0] = v[i].x; s[1] = v[i].y; s[2] = v[i].z; s[3] = v[i].w; }
    LDS_WAIT();
#pragma unroll
    for (int j = 0; j < 8; ++j) { const int dd = lr + 8 * j; LAS const unsigned short* s = scr + (8 * ch) * 66 + dd;
        u32x4 o;
        o.x = (unsigned)s[0 * 66] | ((unsigned)s[1 * 66] << 16); o.y = (unsigned)s[2 * 66] | ((unsigned)s[3 * 66] << 16);
        o.z = (unsigned)s[4 * 66] | ((unsigned)s[5 * 66] << 16); o.w = (unsigned)s[6 * 66] | ((unsigned)s[7 * 66] << 16);
        *(u32x4*)(d.dst + (size_t)dd * d.ldd + 8 * ch) = o; }
    LDS_WAIT();
}
DI u32x4 ld8_bf16(const bf16_t* p) { return *(const u32x4*)p; }
DI u32x4 ld8_f32(const float* p) { const f32x4 a = *(const f32x4*)p, b = *(const f32x4*)(p + 4); u32x4 o; o.x = pk2(a.x, a.y); o.y = pk2(a.z, a.w); o.z = pk2(b.x, b.y); o.w = pk2(b.z, b.w); return o; }

DI void phase_prep0(const Params& p, LAS unsigned char* lds) {
    const int tid = otid(), lane = tid & 63, wave = tid >> 6;
    const int gw = blockIdx.x * 8 + wave, NGW = gridDim.x * 8;
    bf16_t* P = (bf16_t*)(p.ws + WS_RB);
    unsigned char* RA = p.ws + WS_RA;
    bf16_t* rKt = (bf16_t*)(RA + RA_RKT); bf16_t* rVt = (bf16_t*)(RA + RA_RVT);
    bf16_t* gKc = (bf16_t*)(RA + RA_GKC); bf16_t* gKs = (bf16_t*)(RA + RA_GKS);
    bf16_t* gVtc = (bf16_t*)(RA + RA_GVTC); bf16_t* gVts = (bf16_t*)(RA + RA_GVTS);
    LAS float* rt = (LAS float*)lds;
    for (int e = tid; e < 1024; e += 512) { const int pos = e >> 4, i = e & 15; const float inv = powf(10000.f, -(float)i / 16.f); const float ang = (float)pos * inv;
        rt[e] = cosf(ang); rt[1024 + e] = sinf(ang); }
    __syncthreads();
    LAS unsigned short* scr = (LAS unsigned short*)(lds + 16384 + wave * 8704);
    constexpr int NA_ = 640 * 8, NB_ = 640 * 8, NC_ = 128 * 2, ND_ = 512 * 2, NE_ = 64, NTOT_ = NA_ + NB_ + NC_ + ND_ + NE_;
    auto item_of = [&](int it) {
        TItem d; d.f32 = 0; d.lds_ = 2816;
        int r = it;
        if (r < NA_ + NB_) { const int isv = r >= NA_; if (isv) r -= NA_; const int tb = r >> 3, h = r & 7, t0 = 64 * tb;
            d.src = P + (size_t)t0 * 2816 + (isv ? 1024 : 512) + 64 * h; d.dst = (isv ? rVt : rKt) + (size_t)(64 * h) * T + t0; d.ldd = (size_t)T; return d; }
        r -= NA_ + NB_;
        if (r < NC_) { const int tb = r >> 1, kvh = r & 1, t0 = 64 * tb, b = t0 >> 8;
            d.src = P + (size_t)t0 * 2816 + 2688 + 64 * kvh; d.dst = gVtc + (size_t)(b * 128 + 64 * kvh) * 256 + (t0 & 255); d.ldd = 256; return d; }
        r -= NC_;
        if (r < ND_) { const int tb = r >> 1, kvh = r & 1, n0g = 64 * tb, b = n0g >> 12, n0 = n0g & 4095;
            d.src = P + (size_t)(TC + n0g) * 2816 + 2688 + 64 * kvh; d.dst = gVts + (size_t)(b * 128 + 64 * kvh) * 4352 + n0; d.ldd = 4352; return d; }
        r -= ND_;
        { const int b = r >> 3, pb = (r >> 1) & 3, kvh = r & 1;
            d.src = p.in[3] + ((size_t)(b * 256 + 64 * pb) * 2 + kvh) * 64; d.lds_ = 128; d.f32 = 1; d.dst = gVts + (size_t)(b * 128 + 64 * kvh) * 4352 + 4096 + 64 * pb; d.ldd = 4352; return d; }
    };
    for (int it = gw; it < NTOT_; it += 2 * NGW) {
        const int it2 = it + NGW; const bool has2 = it2 < NTOT_;
        const TItem dA = item_of(it); const TItem dB = item_of(has2 ? it2 : it);
        u32x4 vA[8], vB[8];
        titem_load(dA, vA, lane);
        if (has2) titem_load(dB, vB, lane);
        titem_finish(dA, vA, scr, lane);
        if (has2) titem_finish(dB, vB, scr, lane);
    }
    for (int e8 = blockIdx.x * 512 + tid; e8 < 8 * 256 * 128 / 8; e8 += gridDim.x * 512) { const int e = e8 * 8, b = e >> 15, rem = e & 32767;
        *(u32x4*)(gKs + (size_t)(b * 4352 + 4096) * 128 + rem) = ld8_f32(p.in[2] + e); }
    const float* qn = p.in[21]; const float* kn = p.in[22];
    const int sub = lane & 7;
    float qnw[8], knw[8];
#pragma unroll
    for (int j = 0; j < 8; ++j) { qnw[j] = qn[8 * sub + j] * (0.125f * LOG2E); knw[j] = kn[8 * sub + j]; }
    u32x4 nq = (u32x4){0u, 0u, 0u, 0u}, nk = nq, nv = nq;
#define PREP_LOADRAW(t_) do { const bf16_t* pr_ = P + (size_t)(t_) * 2816; nq = *(const u32x4*)(pr_ + 2048 + 8 * lane); nk = *(const u32x4*)(pr_ + 2560 + 8 * (lane & 15)); nv = *(const u32x4*)(pr_ + 2688 + 8 * (lane & 15)); } while (0)
    if (gw < T) PREP_LOADRAW(gw);
    for (int t = gw; t < T; t += NGW) {
        bf16_t* pr = P + (size_t)t * 2816;
        const u32x4 rawq = nq, rawk = nk, rawv = nv;
        if (t + NGW < T) PREP_LOADRAW(t + NGW);
        const bool smp = t >= TC; const int n = (t - TC) & 4095, bb = (t - TC) >> 12;
        const int pos = (sub < 4) ? (n >> 6) : (n & 63);
        float cs[8], sn[8];
#pragma unroll
        for (int j = 0; j < 8; ++j) { const int i = 8 * (sub & 1) + j; cs[j] = rt[pos * 16 + i]; sn[j] = rt[1024 + pos * 16 + i]; }
        const bool isx2 = (sub >> 1) & 1;
        { const u32x4 raw = rawq;
          float v[8] = {bflo(raw.x), bfhi(raw.x), bflo(raw.y), bfhi(raw.y), bflo(raw.z), bfhi(raw.z), bflo(raw.w), bfhi(raw.w)};
          float ss = 0.f;
#pragma unroll
          for (int j = 0; j < 8; ++j) ss += v[j] * v[j];
          ss += __shfl_xor(ss, 1); ss += __shfl_xor(ss, 2); ss += __shfl_xor(ss, 4);
          const float rs = rsqrtf(ss * (1.f / 64.f) + 1e-6f);
#pragma unroll
          for (int j = 0; j < 8; ++j) v[j] = v[j] * rs * qnw[j];
          if (smp) {
#pragma unroll
              for (int j = 0; j < 8; ++j) { const float pv = __shfl_xor(v[j], 2); v[j] = isx2 ? (v[j] * cs[j] + pv * sn[j]) : (v[j] * cs[j] - pv * sn[j]); }
          }
          u32x4 o; o.x = pk2(v[0], v[1]); o.y = pk2(v[2], v[3]); o.z = pk2(v[4], v[5]); o.w = pk2(v[6], v[7]);
          *(u32x4*)(pr + 2048 + 8 * lane) = o; }
        { const u32x4 raw = rawk;
          float v[8] = {bflo(raw.x), bfhi(raw.x), bflo(raw.y), bfhi(raw.y), bflo(raw.z), bfhi(raw.z), bflo(raw.w), bfhi(raw.w)};
          float ss = 0.f;
#pragma unroll
          for (int j = 0; j < 8; ++j) ss += v[j] * v[j];
          ss += __shfl_xor(ss, 1); ss += __shfl_xor(ss, 2); ss += __shfl_xor(ss, 4);
          const float rs = rsqrtf(ss * (1.f / 64.f) + 1e-6f);
#pragma unroll
          for (int j = 0; j < 8; ++j) v[j] = v[j] * rs * knw[j];
          if (!smp) {
              if (lane < 16) {
                  float* ok = p.out + O_GK + (size_t)t * 128 + 8 * lane;
                  *(f32x4*)ok = (f32x4){v[0], v[1], v[2], v[3]}; *(f32x4*)(ok + 4) = (f32x4){v[4], v[5], v[6], v[7]};
                  u32x4 o; o.x = pk2(v[0], v[1]); o.y = pk2(v[2], v[3]); o.z = pk2(v[4], v[5]); o.w = pk2(v[6], v[7]);
                  *(u32x4*)(gKc + (size_t)t * 128 + 8 * lane) = o;
                  const u32x4 rv = rawv;
                  float* ov = p.out + O_GV + (size_t)t * 128 + 8 * lane;
                  *(f32x4*)ov = (f32x4){bflo(rv.x), bfhi(rv.x), bflo(rv.y), bfhi(rv.y)}; *(f32x4*)(ov + 4) = (f32x4){bflo(rv.z), bfhi(rv.z), bflo(rv.w), bfhi(rv.w)};
              }
          } else {
#pragma unroll
              for (int j = 0; j < 8; ++j) { const float pv = __shfl_xor(v[j], 2); v[j] = isx2 ? (v[j] * cs[j] + pv * sn[j]) : (v[j] * cs[j] - pv * sn[j]); }
              if (lane < 16) { u32x4 o; o.x = pk2(v[0], v[1]); o.y = pk2(v[2], v[3]); o.z = pk2(v[4], v[5]); o.w = pk2(v[6], v[7]);
                  *(u32x4*)(gKs + (size_t)(bb * 4352 + n) * 128 + 8 * lane) = o; }
          } }
    }
}

#undef PREP_LOADRAW
DI void phase_prep1(const Params& p, LAS unsigned char* lds) {
    const int tid = otid(), lane = tid & 63, wave = tid >> 6;
    const int gw = blockIdx.x * 8 + wave, NGW = gridDim.x * 8;
    const bf16_t* P = (const bf16_t*)(p.ws + WS_RB);
    unsigned char* RA = p.ws + WS_RA;
    bf16_t* nVt = (bf16_t*)(RA + RA_NVT); bf16_t* nKc = (bf16_t*)(RA + RA_NKC); bf16_t* nVtc = (bf16_t*)(RA + RA_NVTC);
    LAS unsigned short* scr = (LAS unsigned short*)(lds + wave * 8704);
    constexpr int NA_ = 640 * 16, NB_ = 8 * 4 * 16, NTOT_ = NA_ + NB_;
    auto item_of = [&](int it) {
        TItem d; d.f32 = 0; d.lds_ = 3072;
        int r = it;
        if (r < NA_) { const int tb = r >> 4, hd = r & 15, t0 = 64 * tb;
            d.src = P + (size_t)t0 * 3072 + 2048 + 64 * hd; d.dst = nVt + (size_t)(64 * hd) * T + t0; d.ldd = (size_t)T; return d; }
        r -= NA_;
        { const int b = r >> 6, pb = (r >> 4) & 3, hd = r & 15;
            d.src = p.in[7] + ((size_t)(b * 256 + 64 * pb) * 16 + hd) * 64; d.lds_ = 1024; d.f32 = 1; d.dst = nVtc + (size_t)(b * 1024 + 64 * hd) * 256 + 64 * pb; d.ldd = 256; return d; }
    };
    for (int it = gw; it < NTOT_; it += 2 * NGW) {
        const int it2 = it + NGW; const bool has2 = it2 < NTOT_;
        const TItem dA = item_of(it); const TItem dB = item_of(has2 ? it2 : it);
        u32x4 vA[8], vB[8];
        titem_load(dA, vA, lane);
        if (has2) titem_load(dB, vB, lane);
        titem_finish(dA, vA, scr, lane);
        if (has2) titem_finish(dB, vB, scr, lane);
    }
    for (int e8 = blockIdx.x * 512 + tid; e8 < 8 * 256 * 1024 / 8; e8 += gridDim.x * 512) *(u32x4*)(nKc + (size_t)e8 * 8) = ld8_f32(p.in[6] + (size_t)e8 * 8);
#pragma unroll 4
    for (int e = blockIdx.x * 512 + tid; e < TC * 256; e += gridDim.x * 512) { const int t = e >> 8, c8 = (e & 255) * 8;
        const u32x4 rv = *(const u32x4*)(P + (size_t)t * 3072 + 1024 + c8);
        float* o = (c8 < 1024) ? p.out + O_NK + (size_t)t * 1024 + c8 : p.out + O_NV + (size_t)t * 1024 + (c8 - 1024);
        *(f32x4*)o = (f32x4){bflo(rv.x), bfhi(rv.x), bflo(rv.y), bfhi(rv.y)}; *(f32x4*)(o + 4) = (f32x4){bflo(rv.z), bfhi(rv.z), bflo(rv.w), bfhi(rv.w)}; }
}

DI float log2_sigmoid(float x) { return -log1pf(expf(-x)) * LOG2E; }

DI void phase_r1(const Params& p) {
    const int tid = otid(), lane = tid & 63, wave = tid >> 6, r = lane & 31, hh = lane >> 5;
    const int gw = blockIdx.x * 8 + wave, NGW = gridDim.x * 8;
    unsigned char* RA = p.ws + WS_RA;
    const bf16_t* rKt = (const bf16_t*)(RA + RA_RKT); const bf16_t* rVt = (const bf16_t*)(RA + RA_RVT);
    float* KVs = (float*)(RA + RA_KVS);
    for (int it = gw; it < 160 * 8 * 2; it += NGW) {
        const int dir = it & 1, cidx = it >> 4, h = (it >> 1) & 7, t0 = 256 * cidx;
        const bool ctx = cidx < 32;
        const float l2 = log2_sigmoid(p.in[dir ? 19 : 18][h]);
        const float wa = dir ? 0.f : 255.f, ws = dir ? 1.f : -1.f;
        f32x16 acc[2][2];
#pragma unroll
        for (int a = 0; a < 2; ++a)
#pragma unroll
            for (int b = 0; b < 2; ++b)
#pragma unroll
                for (int i = 0; i < 16; ++i) acc[a][b][i] = 0.f;
        const bf16_t* vb = rVt + (size_t)(64 * h + r) * T + t0 + 8 * hh;
        const bf16_t* kb = rKt + (size_t)(64 * h + r) * T + t0 + 8 * hh;
#pragma unroll 2
        for (int ks = 0; ks < 16; ++ks) {
            const int j0 = 16 * ks + 8 * hh;
            bf16x8 aV[2], bK[2];
            float wj[8];
#pragma unroll
            for (int jj = 0; jj < 8; ++jj) wj[jj] = 0.125f * fexp2((wa + ws * (float)(j0 + jj)) * l2);
#pragma unroll
            for (int blk = 0; blk < 2; ++blk) {
                aV[blk] = *(const bf16x8*)(vb + (size_t)(32 * blk) * T + 16 * ks);
                const u32x4 kr = *(const u32x4*)(kb + (size_t)(32 * blk) * T + 16 * ks);
                u32x4 ow;
                ow.x = pk2(bflo(kr.x) * wj[0], bfhi(kr.x) * wj[1]); ow.y = pk2(bflo(kr.y) * wj[2], bfhi(kr.y) * wj[3]);
                ow.z = pk2(bflo(kr.z) * wj[4], bfhi(kr.z) * wj[5]); ow.w = pk2(bflo(kr.w) * wj[6], bfhi(kr.w) * wj[7]);
                bK[blk] = __builtin_bit_cast(bf16x8, ow);
            }
#pragma unroll
            for (int a = 0; a < 2; ++a)
#pragma unroll
                for (int b = 0; b < 2; ++b) {
                    const bf16x8 Af = ctx ? bK[a] : aV[a], Bf = ctx ? aV[b] : bK[b];
                    acc[a][b] = MFMA32(Af, Bf, acc[a][b]);
                }
        }
        float* od;
        if (ctx) od = p.out + (dir ? O_RB : O_RF) + (size_t)(cidx * 8 + h) * 4096;
        else { const int bc = cidx - 32, b = bc >> 4, c = bc & 15; od = KVs + ((size_t)((b * 8 + h) * 16 + c) * 2 + dir) * 4096; }
#pragma unroll
        for (int a = 0; a < 2; ++a)
#pragma unroll
            for (int b = 0; b < 2; ++b)
#pragma unroll
                for (int i = 0; i < 16; ++i) od[(32 * a + crow(i, hh)) * 64 + 32 * b + r] = acc[a][b][i];
    }
}
DI void phase_r2(const Params& p) {
    unsigned char* RA = p.ws + WS_RA;
    const float* KVs = (const float*)(RA + RA_KVS); bf16_t* FB = (bf16_t*)(RA + RA_FB);
    const int tid2 = otid();
    for (int e = blockIdx.x * 512 + tid2; e < 64 * 2 * 4096; e += gridDim.x * 512) {
        const int bh = e >> 13, dir = (e >> 12) & 1, el = e & 4095, dv = el >> 6, dk = el & 63, h = bh & 7;
        const float l2 = log2_sigmoid(p.in[dir ? 19 : 18][h]);
        const float gC = fexp2(256.f * l2);
        float S = p.in[dir ? 5 : 4][(size_t)bh * 4096 + dk * 64 + dv];
        if (dir == 0) { for (int c = 0; c < 16; ++c) { const size_t o = ((size_t)(bh * 16 + c) * 2) * 4096 + el; FB[o] = f2bf(S); S = gC * S + KVs[o]; } }
        else { for (int c = 15; c >= 0; --c) { const size_t o = ((size_t)(bh * 16 + c) * 2 + 1) * 4096 + el; FB[o] = f2bf(S); S = gC * S + KVs[o]; } }
    }
}

enum { MODE_SOFTMAX = 0, MODE_NA = 1, MODE_RET = 2 };
struct AttnUnit {
    const bf16_t* q; int ldq; bf16_t* o; int ldo;
    const bf16_t* k0; int ldk0; const bf16_t* vt0; int ldvt0; int nt0;
    const bf16_t* k1; int ldk1; const bf16_t* vt1; int ldvt1; int nt;
    float sc;
    int r_unit0, rlo;
    float l2f, l2b; const bf16_t* FB; const float* gn;
};
template <int MODE>
DI void attn_unit(LAS unsigned char* lds, const AttnUnit& U, LAS const float* rpbs) {
    const int tid = otid(), lane = tid & 63, w = __builtin_amdgcn_readfirstlane(tid >> 6), qi = lane & 31, hh = lane >> 5;
    const bf16_t* qrow = U.q + (size_t)(32 * w + qi) * U.ldq + 8 * hh;
    bf16x8 bq[4];
#pragma unroll
    for (int ks = 0; ks < 4; ++ks) bq[ks] = *(const bf16x8*)(qrow + 16 * ks);
    f32x16 o0, o1;
#pragma unroll
    for (int i = 0; i < 16; ++i) { o0[i] = 0.f; o1[i] = 0.f; }
    float m_run = -INFINITY, l_run = 0.f;
    const int sr = tid >> 3, scol = (tid & 7) * 8;
    const unsigned stoff = (unsigned)(sr * 72 + scol) * 2u;
    const unsigned vstoffA = (unsigned)(sr * 72 + 16 * ((tid & 7) >> 1) + 4 * (tid & 1)) * 2u;
    u32x4 kreg, vreg;
    const int nr = U.r_unit0 + (w >> 1), ncq = 32 * (w & 1) + qi;
    const int nr0 = min(max(nr - 4, 0), 56), nc0 = min(max(ncq - 8, 0), 48);
    const int iq = 32 * w + qi;
#define ATT_LOAD(t) do { const bf16_t *kp, *vp; if ((t) < U.nt0) { kp = U.k0 + (size_t)(64 * (t) + sr) * U.ldk0 + scol; vp = U.vt0 + (size_t)sr * U.ldvt0 + 64 * (t) + scol; } \
        else { const int t1 = (t) - U.nt0; kp = U.k1 + (size_t)(64 * t1 + sr) * U.ldk1 + scol; vp = U.vt1 + (size_t)sr * U.ldvt1 + 64 * t1 + scol; } \
        kreg = *(const u32x4*)kp; vreg = *(const u32x4*)vp; } while (0)
#define ATT_WRITE(b) do { *(LAS u32x4*)(lds + (b) * 18432 + stoff) = kreg; \
        *(LAS u32x2*)(lds + (b) * 18432 + 9216 + vstoffA) = (u32x2){vreg.x, vreg.y}; *(LAS u32x2*)(lds + (b) * 18432 + 9216 + vstoffA + 16) = (u32x2){vreg.z, vreg.w}; } while (0)
    __syncthreads();
    ATT_LOAD(0); ATT_WRITE(0);
    __syncthreads();
    for (int t = 0; t < U.nt; ++t) {
        const int cur = t & 1;
        if (t + 1 < U.nt) ATT_LOAD(t + 1);
        bool active = true; int dr = 0; bool win = false;
        if (MODE == MODE_NA) { win = t < U.nt0; if (win) { const int kr = U.rlo + t; active = (kr >= nr0) && (kr < nr0 + 8); dr = kr - nr + 7; } }
        if (active) {
            LAS const unsigned char* Kb = lds + cur * 18432; LAS const unsigned char* Vb = Kb + 9216;
            f32x16 s0, s1;
#pragma unroll
            for (int i = 0; i < 16; ++i) { s0[i] = 0.f; s1[i] = 0.f; }
#pragma unroll
            for (int ks = 0; ks < 4; ++ks) {
                const bf16x8 a0 = *(LAS const bf16x8*)(Kb + (qi * 72 + 16 * ks + 8 * hh) * 2);
                const bf16x8 a1 = *(LAS const bf16x8*)(Kb + ((32 + qi) * 72 + 16 * ks + 8 * hh) * 2);
                s0 = MFMA32(a0, bq[ks], s0); s1 = MFMA32(a1, bq[ks], s1);
            }
            if (MODE == MODE_RET) {
#pragma unroll
                for (int i = 0; i < 16; ++i) {
                    const int j0 = 64 * t + crow(i, hh), j1 = j0 + 32;
                    const int d0 = iq - j0, d1 = iq - j1;
                    const float w0 = 0.125f * fexp2(d0 >= 0 ? (float)d0 * U.l2f : (float)(-d0) * U.l2b);
                    const float w1 = 0.125f * fexp2(d1 >= 0 ? (float)d1 * U.l2f : (float)(-d1) * U.l2b);
                    s0[i] *= w0; s1[i] *= w1;
                }
            } else {
                if (MODE == MODE_NA && win) {
                    LAS const float* bp = rpbs + dr * 31 + 15 - ncq;
#pragma unroll
                    for (int i = 0; i < 16; ++i) {
                        const int kc0 = crow(i, hh), kc1 = kc0 + 32;
                        const bool v0 = (unsigned)(kc0 - nc0) < 16u, v1 = (unsigned)(kc1 - nc0) < 16u;
                        const float b0 = v0 ? bp[kc0] : 0.f, b1 = v1 ? bp[kc1] : 0.f;
                        s0[i] = v0 ? s0[i] + b0 : -INFINITY; s1[i] = v1 ? s1[i] + b1 : -INFINITY;
                    }
                }
                float mx = fmaxf(s0[0], s1[0]);
#pragma unroll
                for (int i = 1; i < 16; ++i) mx = fmaxf(fmaxf(mx, s0[i]), s1[i]);
                { const unsigned mu = __float_as_uint(mx); auto r2 = __builtin_amdgcn_permlane32_swap(mu, mu, false, false); mx = fmaxf(__uint_as_float(r2[0]), __uint_as_float(r2[1])); }
                const bool upd = mx > m_run + 8.f;
                if (__builtin_amdgcn_ballot_w64(upd) != 0ull) {
                    const float mn = upd ? mx : m_run;
                    const float alpha = fexp2(m_run - mn);
                    m_run = mn; l_run *= alpha;
#pragma unroll
                    for (int i = 0; i < 16; ++i) { o0[i] *= alpha; o1[i] *= alpha; }
                }
                const f32x2 mm = (f32x2){m_run, m_run};
                f32x2 ps2 = (f32x2){0.f, 0.f};
#pragma unroll
                for (int i = 0; i < 8; ++i) {
                    const f32x2 t0 = (f32x2){s0[2 * i], s0[2 * i + 1]} - mm, t1 = (f32x2){s1[2 * i], s1[2 * i + 1]} - mm;
                    s0[2 * i] = fexp2(t0.x); s0[2 * i + 1] = fexp2(t0.y); s1[2 * i] = fexp2(t1.x); s1[2 * i + 1] = fexp2(t1.y);
                    ps2 += (f32x2){s0[2 * i], s0[2 * i + 1]}; ps2 += (f32x2){s1[2 * i], s1[2 * i + 1]};
                }
                l_run += ps2.x + ps2.y;
            }
#pragma unroll
            for (int kb = 0; kb < 2; ++kb)
#pragma unroll
                for (int s = 0; s < 2; ++s) {
                    u32x4 pw;
                    if (kb == 0) { pw.x = pk2(s0[8 * s], s0[8 * s + 1]); pw.y = pk2(s0[8 * s + 2], s0[8 * s + 3]); pw.z = pk2(s0[8 * s + 4], s0[8 * s + 5]); pw.w = pk2(s0[8 * s + 6], s0[8 * s + 7]); }
                    else { pw.x = pk2(s1[8 * s], s1[8 * s + 1]); pw.y = pk2(s1[8 * s + 2], s1[8 * s + 3]); pw.z = pk2(s1[8 * s + 4], s1[8 * s + 5]); pw.w = pk2(s1[8 * s + 6], s1[8 * s + 7]); }
                    const bf16x8 pb = __builtin_bit_cast(bf16x8, pw);
                    const int koff = (32 * kb + 16 * s + 8 * hh) * 2;
                    const bf16x8 aV0 = *(LAS const bf16x8*)(Vb + (qi * 72) * 2 + koff);
                    const bf16x8 aV1 = *(LAS const bf16x8*)(Vb + ((32 + qi) * 72) * 2 + koff);
                    o0 = MFMA32(aV0, pb, o0); o1 = MFMA32(aV1, pb, o1);
                }
        }
        if (t + 1 < U.nt) ATT_WRITE(cur ^ 1);
        __syncthreads();
    }
#undef ATT_LOAD
#undef ATT_WRITE
    bf16_t* orow = U.o + (size_t)(32 * w + qi) * U.ldo;
    if (MODE == MODE_RET) {
        if (U.FB) {
            f32x16 c0, c1, e0, e1;
#pragma unroll
            for (int i = 0; i < 16; ++i) { c0[i] = 0.f; c1[i] = 0.f; e0[i] = 0.f; e1[i] = 0.f; }
            const bf16_t* Fp = U.FB + (size_t)qi * 64 + 8 * hh; const bf16_t* Bp = Fp + 4096;
#pragma unroll
            for (int ks = 0; ks < 4; ++ks) {
                const bf16x8 f0 = *(const bf16x8*)(Fp + 16 * ks), f1 = *(const bf16x8*)(Fp + 2048 + 16 * ks);
                const bf16x8 g0 = *(const bf16x8*)(Bp + 16 * ks), g1 = *(const bf16x8*)(Bp + 2048 + 16 * ks);
                c0 = MFMA32(f0, bq[ks], c0); c1 = MFMA32(f1, bq[ks], c1); e0 = MFMA32(g0, bq[ks], e0); e1 = MFMA32(g1, bq[ks], e1);
            }
            const float wf = fexp2((float)(iq + 1) * U.l2f), wb = fexp2((float)(256 - iq) * U.l2b);
#pragma unroll
            for (int i = 0; i < 16; ++i) { o0[i] += wf * c0[i] + wb * e0[i]; o1[i] += wf * c1[i] + wb * e1[i]; }
        }
        float s = 0.f;
#pragma unroll
        for (int i = 0; i < 16; ++i) s += o0[i] + o1[i];
        s += __shfl_xor(s, 32);
        const float mu = s * (1.f / 64.f);
        float vs = 0.f;
#pragma unroll
        for (int i = 0; i < 16; ++i) { const float a = o0[i] - mu, b = o1[i] - mu; vs += a * a + b * b; }
        vs += __shfl_xor(vs, 32);
        const float rstd = rsqrtf(vs * (1.f / 64.f) + 1e-5f);
#pragma unroll
        for (int db = 0; db < 2; ++db)
#pragma unroll
            for (int g = 0; g < 4; ++g) { const int d = 32 * db + 8 * g + 4 * hh;
                const u32x2 graw = *(const u32x2*)(orow + d);
                const f32x4 gw = *(const f32x4*)(U.gn + d);
                const float g0 = silu_f(bflo(graw.x)), g1 = silu_f(bfhi(graw.x)), g2 = silu_f(bflo(graw.y)), g3 = silu_f(bfhi(graw.y));
                const float x0 = (db ? o1[4 * g] : o0[4 * g]), x1 = (db ? o1[4 * g + 1] : o0[4 * g + 1]), x2 = (db ? o1[4 * g + 2] : o0[4 * g + 2]), x3 = (db ? o1[4 * g + 3] : o0[4 * g + 3]);
                u32x2 ov; ov.x = pk2((x0 - mu) * rstd * gw.x * g0, (x1 - mu) * rstd * gw.y * g1); ov.y = pk2((x2 - mu) * rstd * gw.z * g2, (x3 - mu) * rstd * gw.w * g3);
                *(u32x2*)(orow + d) = ov; }
    } else {
        float l; { const unsigned lu = __float_as_uint(l_run); auto r2 = __builtin_amdgcn_permlane32_swap(lu, lu, false, false); l = __uint_as_float(r2[0]) + __uint_as_float(r2[1]); }
        const float inv = 1.f / l;
#pragma unroll
        for (int db = 0; db < 2; ++db)
#pragma unroll
            for (int g = 0; g < 4; ++g) { const int d = 32 * db + 8 * g + 4 * hh;
                const float x0 = (db ? o1[4 * g] : o0[4 * g]), x1 = (db ? o1[4 * g + 1] : o0[4 * g + 1]), x2 = (db ? o1[4 * g + 2] : o0[4 * g + 2]), x3 = (db ? o1[4 * g + 3] : o0[4 * g + 3]);
                u32x2 ov; ov.x = pk2(x0 * inv, x1 * inv); ov.y = pk2(x2 * inv, x3 * inv);
                *(u32x2*)(orow + d) = ov; }
    }
}

DI void phase_att0(const Params& p, LAS unsigned char* lds, bool dummy = false) {
    bf16_t* P = (bf16_t*)(p.ws + WS_RB);
    unsigned char* RA = p.ws + WS_RA;
    const bf16_t* rVt = (const bf16_t*)(RA + RA_RVT);
    const bf16_t* gKc = (const bf16_t*)(RA + RA_GKC); const bf16_t* gKs = (const bf16_t*)(RA + RA_GKS);
    const bf16_t* gVtc = (const bf16_t*)(RA + RA_GVTC); const bf16_t* gVts = (const bf16_t*)(RA + RA_GVTS);
    const bf16_t* FB = (const bf16_t*)(RA + RA_FB);
    for (int u = blockIdx.x; u < 2560; u += gridDim.x) {
        AttnUnit U;
        U.k1 = nullptr; U.vt1 = nullptr; U.ldk1 = 0; U.ldvt1 = 0; U.r_unit0 = 0; U.rlo = 0; U.l2f = 0.f; U.l2b = 0.f; U.FB = nullptr; U.gn = nullptr;
        U.sc = 0.125f * LOG2E;
        if (u < 1024) {
            int b, kvh, rem2;
            if (gridDim.x == 256) { const int x = blockIdx.x & 7, slot = blockIdx.x >> 3, k = u >> 8, set = x + 8 * (k >> 1); b = set >> 1; kvh = set & 1; rem2 = (k & 1) * 32 + slot; }
            else { b = u >> 7; const int rem = u & 127; kvh = rem >> 6; rem2 = rem & 63; }
            const int qh = 4 * kvh + (rem2 >> 4), qb = rem2 & 15;
            U.q = P + (size_t)(TC + b * 4096 + qb * 256) * 2816 + 2048 + 64 * qh; U.ldq = 2816; U.o = (bf16_t*)U.q; U.ldo = 2816;
            U.k0 = gKs + (size_t)b * 4352 * 128 + 64 * kvh; U.ldk0 = 128; U.vt0 = gVts + (size_t)(b * 128 + 64 * kvh) * 4352; U.ldvt0 = 4352; U.nt0 = 68; U.nt = 68;
            if (dummy) { U.o = (bf16_t*)(p.ws + WS_END); U.ldo = 64; }
            attn_unit<MODE_SOFTMAX>(lds, U, nullptr);
        } else if (u < 1280) {
            const int v = u - 1024, b = v >> 3, qh = v & 7, kvh = qh >> 2;
            U.q = P + (size_t)(b * 256) * 2816 + 2048 + 64 * qh; U.ldq = 2816; U.o = (bf16_t*)U.q; U.ldo = 2816;
            U.k0 = gKc + (size_t)b * 256 * 128 + 64 * kvh; U.ldk0 = 128; U.vt0 = gVtc + (size_t)(b * 128 + 64 * kvh) * 256; U.ldvt0 = 256; U.nt0 = 4; U.nt = 4;
            if (dummy) { U.o = (bf16_t*)(p.ws + WS_END); U.ldo = 64; }
            attn_unit<MODE_SOFTMAX>(lds, U, nullptr);
        } else {
            const int v = u - 1280, cidx = v >> 3, h = v & 7, t0 = 256 * cidx;
            U.q = P + (size_t)t0 * 2816 + 64 * h; U.ldq = 2816; U.o = P + (size_t)t0 * 2816 + 1536 + 64 * h; U.ldo = 2816;
            U.k0 = P + (size_t)t0 * 2816 + 512 + 64 * h; U.ldk0 = 2816; U.vt0 = rVt + (size_t)(64 * h) * T + t0; U.ldvt0 = T; U.nt0 = 4; U.nt = 4;
            U.l2f = log2_sigmoid(p.in[18][h]); U.l2b = log2_sigmoid(p.in[19][h]); U.gn = p.in[20] + 64 * h;
            if (cidx >= 32) { const int bc = cidx - 32, b = bc >> 4, c = bc & 15; U.FB = FB + ((size_t)((b * 8 + h) * 16 + c) * 2) * 4096; }
            if (dummy) { U.o = (bf16_t*)(p.ws + WS_END); U.ldo = 64; }
            attn_unit<MODE_RET>(lds, U, nullptr);
        }
    }
}
DI void phase_att1(const Params& p, LAS unsigned char* lds, bool dummy = false) {
    bf16_t* P = (bf16_t*)(p.ws + WS_RB);
    unsigned char* RA = p.ws + WS_RA;
    const bf16_t* nVt = (const bf16_t*)(RA + RA_NVT); const bf16_t* nKc = (const bf16_t*)(RA + RA_NKC); const bf16_t* nVtc = (const bf16_t*)(RA + RA_NVTC);
    LAS float* rpbs = (LAS float*)(lds + 40960);
    for (int u = blockIdx.x; u < 2560; u += gridDim.x) {
        AttnUnit U;
        U.l2f = 0.f; U.l2b = 0.f; U.FB = nullptr; U.gn = nullptr; U.sc = 0.125f * LOG2E;
        if (u < 2048) {
            int b, hd, rg;
            if (gridDim.x == 256) { const int x = blockIdx.x & 7, slot = blockIdx.x >> 3, j = (u >> 8) * 32 + slot, pair = 16 * x + (j >> 4); b = pair >> 4; hd = pair & 15; rg = j & 15; }
            else { b = u >> 8; hd = (u >> 4) & 15; rg = u & 15; }
            const int rlo = min(max(4 * rg - 4, 0), 56), rhi0 = min(max(4 * rg - 1, 0), 56), nwin = rhi0 + 8 - rlo;
            const int tb = TC + b * 4096;
            __syncthreads();
            for (int e = otid(); e < 465; e += 512) rpbs[e] = p.in[25][(size_t)hd * 465 + e] * LOG2E;
            U.q = P + (size_t)(tb + 256 * rg) * 3072 + 64 * hd; U.ldq = 3072; U.o = (bf16_t*)U.q; U.ldo = 3072;
            U.k0 = P + (size_t)(tb + 64 * rlo) * 3072 + 1024 + 64 * hd; U.ldk0 = 3072; U.vt0 = nVt + (size_t)(64 * hd) * T + tb + 64 * rlo; U.ldvt0 = T; U.nt0 = nwin;
            U.k1 = nKc + (size_t)(b * 256) * 1024 + 64 * hd; U.ldk1 = 1024; U.vt1 = nVtc + (size_t)(b * 1024 + 64 * hd) * 256; U.ldvt1 = 256; U.nt = nwin + 4;
            U.r_unit0 = 4 * rg; U.rlo = rlo;
            if (dummy) { U.o = (bf16_t*)(p.ws + WS_END); U.ldo = 64; }
            attn_unit<MODE_NA>(lds, U, rpbs);
        } else {
            const int v = u - 2048, b = v >> 4, hd = v & 15;
            U.k1 = nullptr; U.vt1 = nullptr; U.ldk1 = 0; U.ldvt1 = 0; U.r_unit0 = 0; U.rlo = 0;
            U.q = P + (size_t)(b * 256) * 3072 + 64 * hd; U.ldq = 3072; U.o = (bf16_t*)U.q; U.ldo = 3072;
            U.k0 = P + (size_t)(b * 256) * 3072 + 1024 + 64 * hd; U.ldk0 = 3072; U.vt0 = nVt + (size_t)(64 * hd) * T + b * 256; U.ldvt0 = T; U.nt0 = 4; U.nt = 4;
            if (dummy) { U.o = (bf16_t*)(p.ws + WS_END); U.ldo = 64; }
            attn_unit<MODE_SOFTMAX>(lds, U, nullptr);
        }
    }
}

__global__ void __launch_bounds__(512, 2) fwd_megakernel(Params p) {
    extern __shared__ __attribute__((aligned(16))) unsigned char lds_raw[];
    LAS unsigned char* lds = (LAS unsigned char*)lds_raw;
    cg::grid_group grid = cg::this_grid();
    const int G = gridDim.x;
    float* X = p.out;
    float* mod = (float*)(p.ws + WS_MOD);
    bf16_t* H = (bf16_t*)(p.ws + WS_H); bf16_t* Y = (bf16_t*)(p.ws + WS_Y); bf16_t* PB = (bf16_t*)(p.ws + WS_RB); bf16_t* Y2 = (bf16_t*)(p.ws + WS_END);
    const float* npre = p.in[12]; const float* npost = p.in[13];
    unsigned* barw = (unsigned*)(p.ws + WS_CTL);
    if (blockIdx.x == 0) for (int e = threadIdx.x; e < XCD_BAR_WORDS; e += 512) barw[e] = 0u;
    if (threadIdx.x < 4) ((LAS unsigned*)(lds + 131072))[threadIdx.x] = 0u;
    __syncthreads();
    XcdBarrier xbar; xbar.bar = barw; xbar.x = 0; xbar.st = (volatile LAS unsigned*)(lds + 131072);
#define SYNC() xcd_barrier(xbar)
#define GEMM(Aptr, lda_, Bptr, N_, K_, EPI) do { g8::Gemm g{Aptr, lda_, Bptr, T, N_, K_}; g8::StaticOrder S; S.init(T, N_, K_, G, (int)blockIdx.x); g8::gemm_phase(lds, g, S, EPI); } while (0)
#define GEMM_Y(Aptr, lda_, Bptr, K_) do { g8::Gemm g{Aptr, lda_, Bptr, T, 1024, K_}; g8::SplitOrder S; S.init(K_, (int)blockIdx.x); g8::gemm_phase(lds, g, S, (g8::EpiBf16{Y, 1024, Y2})); } while (0)

    phase_mod(p.in[8], p.in[9], p.in[10], p.in[11], mod, (LAS float*)lds);
    phase_weights(p, lds);
    grid.sync();
    xbar = xcd_barrier_post(barw, (volatile LAS unsigned*)(lds + 131072));
    for (int l = 0; l < 2; ++l) {
        const float* modl = mod + (size_t)l * 9 * 9216;
        if (l == 0) row_phase<false, true, 0, 0>(p.in[0], p.in[1], X, nullptr, nullptr, H, nullptr, 0, 0.f, nullptr, modl, 0, npre + (l * 3 + 0) * 1024);
        else row_phase<true, true, 1, 1>(nullptr, nullptr, X, Y, Y2, H, mod, 8, 0.5f, npost + (0 * 3 + 2) * 1024, modl, 0, npre + (l * 3 + 0) * 1024);
        SYNC();
        GEMM(H, 1024, (const bf16_t*)(p.ws + WS_FIN + (size_t)(l * 2 + 0) * SZ_FIN), 5632, 1024, (g8::EpiSwiGLU{PB}));
        SYNC();
        GEMM_Y(PB, DFF, (const bf16_t*)(p.ws + WS_FOUT + (size_t)(l * 2 + 0) * SZ_FOUT), DFF);
        SYNC();
        if (l == 0) row_phase<true, true, 0, 1>(p.in[0], p.in[1], X, Y, Y2, H, modl, 2, 0.5f, npost + (l * 3 + 0) * 1024, modl, 3, npre + (l * 3 + 1) * 1024);
        else row_phase<true, true, 1, 1>(nullptr, nullptr, X, Y, Y2, H, modl, 2, 0.5f, npost + (l * 3 + 0) * 1024, modl, 3, npre + (l * 3 + 1) * 1024);
        SYNC();
        if (l == 0) {
            GEMM(H, 1024, (const bf16_t*)(p.ws + WS_ABIN), 2816, 1024, (g8::EpiBf16{PB, 2816}));
            SYNC();
            phase_prep0(p, lds);
            SYNC();
            phase_r1(p);
            SYNC();
            phase_r2(p);
            SYNC();
            if (PROBE & 2) { phase_att0(p, lds, true); SYNC(); }
            phase_att0(p, lds);
            SYNC();
            GEMM_Y(PB + 1536, 2816, (const bf16_t*)(p.ws + WS_ABOUT), 1024);
        } else {
            GEMM(H, 1024, (const bf16_t*)(p.ws + WS_NAQKV), 3072, 1024, (g8::EpiBf16{PB, 3072}));
            SYNC();
            phase_prep1(p, lds);
            SYNC();
            if (PROBE & 2) { phase_att1(p, lds, true); SYNC(); }
            phase_att1(p, lds);
            SYNC();
            GEMM_Y(PB, 3072, (const bf16_t*)(p.ws + WS_NAOUT), 1024);
        }
        SYNC();
        row_phase<true, true, 1, 1>(nullptr, nullptr, X, Y, Y2, H, modl, 5, 1.0f, npost + (l * 3 + 1) * 1024, modl, 6, npre + (l * 3 + 2) * 1024);
        SYNC();
        GEMM(H, 1024, (const bf16_t*)(p.ws + WS_FIN + (size_t)(l * 2 + 1) * SZ_FIN), 5632, 1024, (g8::EpiSwiGLU{PB}));
        SYNC();
        GEMM_Y(PB, DFF, (const bf16_t*)(p.ws + WS_FOUT + (size_t)(l * 2 + 1) * SZ_FOUT), DFF);
        SYNC();
    }
    row_phase<true, false, 1, 2>(nullptr, nullptr, X, Y, Y2, nullptr, mod + (size_t)9 * 9216, 8, 0.5f, npost + (1 * 3 + 2) * 1024, nullptr, 0, nullptr);
}

extern "C" void kernel_launch(void* const* d_in, const int* in_sizes, int n_in, void* d_out, int out_size, void* d_ws, size_t ws_size, hipStream_t stream) {
    static int grid = 0;
    if (grid == 0) {
        int dev = 0, cus = 0, per_cu = 0;
        hipGetDevice(&dev);
        hipDeviceGetAttribute(&cus, hipDeviceAttributeMultiprocessorCount, dev);
        if (hipFuncSetAttribute((const void*)fwd_megakernel, hipFuncAttributeMaxDynamicSharedMemorySize, LDS_BYTES) != hipSuccess) fprintf(stderr, "kernel_launch: hipFuncSetAttribute failed\n");
        hipOccupancyMaxActiveBlocksPerMultiprocessor(&per_cu, (const void*)fwd_megakernel, 512, LDS_BYTES);
        (void)hipGetLastError();
        if (per_cu < 1) { fprintf(stderr, "kernel_launch: occupancy query says %d blocks/CU\n", per_cu); per_cu = 1; }
        grid = cus;
        if (ws_size < WS_END) fprintf(stderr, "kernel_launch: workspace too small: %zu < %zu\n", ws_size, (size_t)WS_END);
        if (n_in != 26) fprintf(stderr, "kernel_launch: expected 26 inputs, got %d\n", n_in);
    }
    Params p{};
    for (int i = 0; i < 26; ++i) p.in[i] = (const float*)d_in[i];
    p.out = (float*)d_out; p.ws = (unsigned char*)d_ws;
    void* args[] = {&p};
    hipError_t e = hipLaunchCooperativeKernel((const void*)fwd_megakernel, dim3(grid), dim3(512), args, LDS_BYTES, stream);
    if (e != hipSuccess) fprintf(stderr, "cooperative launch failed: %s (grid %d)\n", hipGetErrorString(e), grid);
}
```
